# Optimizing an MI355X kernel written in HIP

```python
import math
import jax, jax.numpy as jnp
from jax import lax
import numpy as np

D_MODEL = 2048
BATCH = 4
SEQ = 8192
DEPTH = 1

MEM_LEN = 256
D_MIX = D_MODEL
POOL_WIDTH = D_MIX // 4
POOL_WINDOWS = (2, 4, 8, 16)
POOL_GROUPS = len(POOL_WINDOWS)
POOL_GROUP_DIM = POOL_WIDTH // POOL_GROUPS
MLA_V_DIM = 128
MLA_HEADS = (D_MIX // 2) // MLA_V_DIM
MLA_NOPE_DIM = 128
MLA_ROPE_DIM = 64
MLA_QK_DIM = MLA_NOPE_DIM + MLA_ROPE_DIM
Q_LORA_RANK = 512
KV_LORA_RANK = 256
X_HEADS = 4
X_WIDTH = D_MIX // 4
X_HEAD_DIM = X_WIDTH // X_HEADS
D_FF = 5632
CONV_WIDTH = 3
ROPE_THETA = 10000.0
NORM_EPS = 1e-6
Q_BLOCK = 128

IN_COLS = POOL_WIDTH + Q_LORA_RANK + KV_LORA_RANK + MLA_ROPE_DIM + X_WIDTH
IN_SPLITS = (
    POOL_WIDTH,
    POOL_WIDTH + Q_LORA_RANK,
    POOL_WIDTH + Q_LORA_RANK + KV_LORA_RANK,
    POOL_WIDTH + Q_LORA_RANK + KV_LORA_RANK + MLA_ROPE_DIM,
)

kernel_name = "hybrid_pool_mla_memxattn_convglu"


def rms_norm(x, g):
    xf = x.astype(jnp.float32)
    y = xf * lax.rsqrt(jnp.mean(xf * xf, axis=-1, keepdims=True) + NORM_EPS)
    return (y * g.astype(jnp.float32)).astype(x.dtype)


def apply_rope(x, pos):
    half = x.shape[-1] // 2
    inv_freq = 1.0 / (ROPE_THETA ** (jnp.arange(half, dtype=jnp.float32) / half))
    ang = pos.astype(jnp.float32)[:, None] * inv_freq[None, :]
    cos = jnp.cos(ang)[None, :, None, :]
    sin = jnp.sin(ang)[None, :, None, :]
    xf = x.astype(jnp.float32)
    x1, x2 = xf[..., :half], xf[..., half:]
    return jnp.concatenate([x1 * cos - x2 * sin, x2 * cos + x1 * sin], axis=-1).astype(x.dtype)


def pool_mixer(p, w_pool, pool_scale):
    B, S, _ = p.shape
    pf = p.astype(jnp.float32).reshape(B, S, POOL_GROUPS, POOL_GROUP_DIM)
    csum = jnp.cumsum(pf, axis=1)
    t = jnp.arange(S)
    outs = []
    for gi, w in enumerate(POOL_WINDOWS):
        cg = csum[:, :, gi]
        lag = jnp.pad(cg, ((0, 0), (w, 0), (0, 0)))[:, :S]
        cnt = jnp.minimum(t + 1, w).astype(jnp.float32)[None, :, None]
        outs.append((cg - lag) / cnt - pf[:, :, gi])
    d = jnp.stack(outs, axis=2).astype(p.dtype)
    y = jnp.einsum('bsgc,gcd->bsgd', d, w_pool).reshape(B, S, POOL_WIDTH)
    return y * pool_scale


def causal_attention_blocks(q, k, v):
    B, S, H, D = q.shape
    Dv = v.shape[-1]
    nb = S // Q_BLOCK
    scale = 1.0 / math.sqrt(D)
    qb = q.reshape(B, nb, Q_BLOCK, H, D).transpose(1, 0, 2, 3, 4)
    kpos = jnp.arange(S)

    def one_block(args):
        qblk, i = args
        qpos = i * Q_BLOCK + jnp.arange(Q_BLOCK)
        s = jnp.einsum('bqhd,bkhd->bhqk', qblk, k).astype(jnp.float32) * scale
        mask = kpos[None, :] <= qpos[:, None]
        s = jnp.where(mask[None, None], s, -jnp.inf)
        pr = jax.nn.softmax(s, axis=-1).astype(v.dtype)
        return jnp.einsum('bhqk,bkhd->bqhd', pr, v)

    o = lax.map(one_block, (qb, jnp.arange(nb)))
    return o.transpose(1, 0, 2, 3, 4).reshape(B, S, H, Dv)


def mla_mixer(q_lat, kv_lat, k_rope, pos, g_q_lat, w_q_up, g_kv_lat, w_kv_up, g_q_mla, g_k_mla):
    B, S, _ = q_lat.shape
    q = (rms_norm(q_lat, g_q_lat) @ w_q_up).reshape(B, S, MLA_HEADS, MLA_QK_DIM)
    kv = (rms_norm(kv_lat, g_kv_lat) @ w_kv_up).reshape(B, S, MLA_HEADS, MLA_NOPE_DIM + MLA_V_DIM)
    k_nope, v = kv[..., :MLA_NOPE_DIM], kv[..., MLA_NOPE_DIM:]
    k_r = jnp.broadcast_to(k_rope[:, :, None, :], (B, S, MLA_HEADS, MLA_ROPE_DIM))
    k = jnp.concatenate([k_nope, k_r], axis=-1)
    q = rms_norm(q, g_q_mla)
    k = rms_norm(k, g_k_mla)
    q = jnp.concatenate([q[..., :MLA_NOPE_DIM], apply_rope(q[..., MLA_NOPE_DIM:], pos)], axis=-1)
    k = jnp.concatenate([k[..., :MLA_NOPE_DIM], apply_rope(k[..., MLA_NOPE_DIM:], pos)], axis=-1)
    o = causal_attention_blocks(q, k, v)
    return o.reshape(B, S, MLA_HEADS * MLA_V_DIM)


def memory_cross_attention(xq, mem, g_mem, w_mem_kv, g_q_x, g_k_x):
    B, S, _ = xq.shape
    M = mem.shape[1]
    q = rms_norm(xq.reshape(B, S, X_HEADS, X_HEAD_DIM), g_q_x)
    mkv = rms_norm(mem, g_mem) @ w_mem_kv
    k = rms_norm(mkv[..., :X_WIDTH].reshape(B, M, X_HEADS, X_HEAD_DIM), g_k_x)
    v = mkv[..., X_WIDTH:].reshape(B, M, X_HEADS, X_HEAD_DIM)
    s = jnp.einsum('bshd,bmhd->bhsm', q, k).astype(jnp.float32) * (1.0 / math.sqrt(X_HEAD_DIM))
    pr = jax.nn.softmax(s, axis=-1).astype(v.dtype)
    o = jnp.einsum('bhsm,bmhd->bshd', pr, v)
    return o.reshape(B, S, X_WIDTH)


def conv_glu_ffn(h, w_gate, w_up, conv_w, conv_b, w_down):
    S = h.shape[1]
    g = h @ w_gate
    gp = jnp.pad(g, ((0, 0), (CONV_WIDTH - 1, 0), (0, 0)))
    gc = conv_b
    for j in range(CONV_WIDTH):
        gc = gc + conv_w[j] * gp[:, j:j + S]
    return (jax.nn.silu(gc) * (h @ w_up)) @ w_down


def setup_inputs(seed: int = 0) -> dict:
    key = jax.random.key(seed)
    ks = jax.random.split(key, 24)
    f32 = jnp.float32
    L = DEPTH

    def nrm(k, shape, scale):
        return jax.random.normal(k, shape, f32) * scale

    def gain(k, n):
        return 1.0 + 0.02 * jax.random.normal(k, (L, n), f32)

    return {
        "x": nrm(ks[0], (BATCH, SEQ, D_MODEL), 1.0),
        "mem": nrm(ks[1], (BATCH, MEM_LEN, D_MODEL), 1.0),
        "g_mix": gain(ks[2], D_MODEL),
        "w_in": nrm(ks[3], (L, D_MODEL, IN_COLS), D_MODEL ** -0.5),
        "g_q_lat": gain(ks[4], Q_LORA_RANK),
        "w_q_up": nrm(ks[5], (L, Q_LORA_RANK, MLA_HEADS * MLA_QK_DIM), Q_LORA_RANK ** -0.5),
        "g_kv_lat": gain(ks[6], KV_LORA_RANK),
        "w_kv_up": nrm(ks[7], (L, KV_LORA_RANK, MLA_HEADS * (MLA_NOPE_DIM + MLA_V_DIM)), KV_LORA_RANK ** -0.5),
        "g_q_mla": gain(ks[8], MLA_QK_DIM),
        "g_k_mla": gain(ks[9], MLA_QK_DIM),
        "w_pool": nrm(ks[10], (L, POOL_GROUPS, POOL_GROUP_DIM, POOL_GROUP_DIM), POOL_GROUP_DIM ** -0.5),
        "pool_scale": 1.0 + 0.1 * jax.random.normal(ks[11], (L, POOL_WIDTH), f32),
        "g_mem": gain(ks[12], D_MODEL),
        "w_mem_kv": nrm(ks[13], (L, D_MODEL, 2 * X_WIDTH), D_MODEL ** -0.5),
        "g_q_x": gain(ks[14], X_HEAD_DIM),
        "g_k_x": gain(ks[15], X_HEAD_DIM),
        "w_o": nrm(ks[16], (L, D_MIX, D_MODEL), D_MIX ** -0.5),
        "g_ffn": gain(ks[17], D_MODEL),
        "w_gate": nrm(ks[18], (L, D_MODEL, D_FF), D_MODEL ** -0.5),
        "w_up": nrm(ks[19], (L, D_MODEL, D_FF), D_MODEL ** -0.5),
        "conv_w": nrm(ks[20], (L, CONV_WIDTH, D_FF), CONV_WIDTH ** -0.5),
        "conv_b": nrm(ks[21], (L, D_FF), 0.01),
        "w_down": nrm(ks[22], (L, D_FF, D_MODEL), D_FF ** -0.5),
    }


def reference(x, mem, g_mix, w_in, g_q_lat, w_q_up, g_kv_lat, w_kv_up, g_q_mla, g_k_mla,
              w_pool, pool_scale, g_mem, w_mem_kv, g_q_x, g_k_x, w_o, g_ffn,
              w_gate, w_up, conv_w, conv_b, w_down):
    S = x.shape[1]
    pos = jnp.arange(S)
    for l in range(DEPTH):
        h = rms_norm(x, g_mix[l])
        z = h @ w_in[l]
        z_pool, z_q, z_kv, z_kr, z_mq = jnp.split(z, IN_SPLITS, axis=-1)
        y_pool = pool_mixer(z_pool, w_pool[l], pool_scale[l])
        y_mla = mla_mixer(z_q, z_kv, z_kr, pos, g_q_lat[l], w_q_up[l], g_kv_lat[l],
                          w_kv_up[l], g_q_mla[l], g_k_mla[l])
        y_mem = memory_cross_attention(z_mq, mem, g_mem[l], w_mem_kv[l], g_q_x[l], g_k_x[l])
        x = x + jnp.concatenate([y_pool, y_mla, y_mem], axis=-1) @ w_o[l]
        x = x + conv_glu_ffn(rms_norm(x, g_ffn[l]), w_gate[l], w_up[l], conv_w[l], conv_b[l], w_down[l])
    return x
```

```cpp
#include <hip/hip_runtime.h>
#include <hip/hip_cooperative_groups.h>
#include <cstdio>
#include <cstdint>
#include <cmath>
namespace cg = cooperative_groups;

#ifndef MK_SPLIT
#define MK_SPLIT 0
#endif

constexpr int NB = 4, SEQ = 8192, T = NB * SEQ, DM = 2048, MEML = 256, MROWS = NB * MEML;
constexpr int ZC = 2048;
constexpr int C_POOL = 0, C_Q = 512, C_KV = 1024, C_KR = 1280, C_MQ = 1344, IN_COLS = 1856;
constexpr int DFF = 5632;
constexpr float EPS = 1e-6f;
constexpr int NPHASE = 11;

#define LAS __attribute__((address_space(3)))
typedef unsigned short bf16_t;
typedef short bf16x8 __attribute__((ext_vector_type(8)));
typedef short s16x4 __attribute__((ext_vector_type(4)));
typedef float f32x4 __attribute__((ext_vector_type(4)));
typedef float f32x16 __attribute__((ext_vector_type(16)));
typedef unsigned u32x4 __attribute__((ext_vector_type(4)));
typedef unsigned u32x2 __attribute__((ext_vector_type(2)));

constexpr size_t MiB = 1u << 20;
constexpr size_t WS_SS = 1 * MiB;
constexpr size_t WS_SSQQ = 1 * MiB + 256 * 1024, WS_SSQKV = 1 * MiB + 512 * 1024;
constexpr size_t WS_WIN = 2 * MiB, WS_WQ = 10 * MiB, WS_WKV = 12 * MiB, WS_WPOOL = 13 * MiB, WS_WMEM = 14 * MiB, WS_WO = 18 * MiB;
constexpr size_t WS_WG = 26 * MiB, WS_WU = 48 * MiB, WS_WD = 70 * MiB, WS_MEMN = 92 * MiB, WS_MKV = 96 * MiB, WS_MKF = 98 * MiB, WS_ROPE = 99 * MiB;
constexpr size_t WS_XN = 128 * MiB, WS_Z = 256 * MiB, WS_DP = 384 * MiB, WS_QN = 416 * MiB, WS_KVN = 448 * MiB, WS_XQ = 464 * MiB;
constexpr size_t WS_QR = 496 * MiB, WS_KVR = 592 * MiB, WS_KF = 720 * MiB, WS_Y = 816 * MiB;
constexpr size_t WS_QF = 128 * MiB;
constexpr size_t WS_H2 = 128 * MiB, WS_G = 256 * MiB, WS_ACT = 608 * MiB, WS_END = 960 * MiB;

constexpr int LDS_BYTES = 147456;

struct Params {
    const float* in[23];
    float* out;
    unsigned char* ws;
    float inv_freq[32];
    int ph_lo, ph_hi;
};

__device__ __forceinline__ unsigned f2bf(float f) { unsigned u = __builtin_bit_cast(unsigned, f); return (u + 0x7fffu + ((u >> 16) & 1u)) >> 16; }
__device__ __forceinline__ unsigned cvt_pk_bf16(float lo, float hi) { unsigned r; asm volatile("v_cvt_pk_bf16_f32 %0, %1, %2" : "=v"(r) : "v"(lo), "v"(hi)); return r; }
__device__ __forceinline__ unsigned pk2(float lo, float hi) { return cvt_pk_bf16(lo, hi); }
__device__ __forceinline__ float bflo(unsigned w) { return __uint_as_float(w << 16); }
__device__ __forceinline__ float bfhi(unsigned w) { return __uint_as_float(w & 0xffff0000u); }
__device__ __forceinline__ void unpack8(u32x4 w, float* f) {
    f[0] = bflo(w.x); f[1] = bfhi(w.x); f[2] = bflo(w.y); f[3] = bfhi(w.y); f[4] = bflo(w.z); f[5] = bfhi(w.z); f[6] = bflo(w.w); f[7] = bfhi(w.w);
}
__device__ __forceinline__ u32x4 pack8f(const float* f) { u32x4 w; w.x = pk2(f[0], f[1]); w.y = pk2(f[2], f[3]); w.z = pk2(f[4], f[5]); w.w = pk2(f[6], f[7]); return w; }
__device__ __forceinline__ float wave_sum(float v) {
#pragma unroll
    for (int o = 1; o < 64; o <<= 1) v += __shfl_xor(v, o);
    return v;
}
#define LDS_WAIT() asm volatile("s_waitcnt lgkmcnt(0)" ::: "memory")

namespace pg8 {
constexpr int BM = 256, BK = 64, HALF = 128, HTB = HALF * BK * 2, STAGE_BYTES = 8 * HTB, NXCD = 8, WGM = 8;
__device__ __forceinline__ int lds_byte(int r, int c) { const int st = (r >> 4) * 2 + (c >> 5), rr = r & 15, cc = c & 31, ob = rr * 64 + cc * 2; return st * 1024 + (ob ^ (((ob >> 9) & 1) << 5)); }
__device__ __forceinline__ void stage_rc(int b, int& R, int& C) { const int st = b / 1024, sb = b % 1024, swz = sb ^ (((sb >> 9) & 1) << 5); R = (st >> 1) * 16 + swz / 64; C = (st & 1) * 32 + (swz % 64) / 2; }
__device__ __forceinline__ int perm32(int rho) { const int n = rho >> 4, i = rho & 15; return 8 * (i >> 2) + 4 * n + (i & 3); }

struct Unit { int pm, pn; };
struct Gemm { const bf16_t* A; const bf16_t* Bt; int M, N, K, lda; };

struct StaticOrder {
    int nM, nN, nwg, G, c;
    __device__ void init(int M, int N, int G_, int c_) { nM = M / BM; nN = N / BM; nwg = nM * nN; G = G_; c = c_; }
    __device__ bool next(int i, Unit& u) const {
        const long L = (long)i * G + c; if (L >= nwg) return false;
        int wgid = (int)L; { const int q = nwg / NXCD, r = nwg % NXCD, xcd = wgid % NXCD, off = wgid / NXCD; wgid = (xcd < r ? xcd * (q + 1) : r * (q + 1) + (xcd - r) * q) + off; }
        const int nig = WGM * nN, gid = wgid / nig, fm = gid * WGM, gsz = (nM - fm) < WGM ? (nM - fm) : WGM;
        u.pm = fm + ((wgid % nig) % gsz); u.pn = (wgid % nig) / gsz; return true;
    }
};

struct EpiBf16 {
    static constexpr bool PERM = true, POST = false;
    bf16_t* O; int ldc;
    __device__ __forceinline__ void operator()(const f32x4 (&acc)[2][2][4][2], const Unit& u, int wr, int wc, int fr, int fq) const {
        const int row0 = u.pm * BM + wr * 64 + fr, col0 = u.pn * BM + wc * 32 + 8 * fq;
#pragma unroll
        for (int ai = 0; ai < 2; ++ai)
#pragma unroll
            for (int m = 0; m < 4; ++m) { bf16_t* rowp = O + (size_t)(row0 + ai * HALF + m * 16) * ldc + col0;
#pragma unroll
                for (int bj = 0; bj < 2; ++bj) { const f32x4 v0 = acc[ai][bj][m][0], v1 = acc[ai][bj][m][1];
                    u32x4 w; w.x = cvt_pk_bf16(v0[0], v0[1]); w.y = cvt_pk_bf16(v0[2], v0[3]); w.z = cvt_pk_bf16(v1[0], v1[1]); w.w = cvt_pk_bf16(v1[2], v1[3]);
                    *(u32x4*)(rowp + bj * HALF) = w; } }
    }
};
struct EpiResF32 {
    static constexpr bool PERM = false, POST = false;
    const float* base; float* out; int ldc;
    __device__ __forceinline__ void operator()(const f32x4 (&acc)[2][2][4][2], const Unit& u, int wr, int wc, int fr, int fq) const {
        const int row0 = u.pm * BM + wr * 64 + fr, col0 = u.pn * BM + wc * 32 + 4 * fq;
#pragma unroll
        for (int ai = 0; ai < 2; ++ai)
#pragma unroll
            for (int m = 0; m < 4; ++m) { const size_t off = (size_t)(row0 + ai * HALF + m * 16) * ldc + col0;
                f32x4 bs[2][2];
#pragma unroll
                for (int bj = 0; bj < 2; ++bj)
#pragma unroll
                    for (int n = 0; n < 2; ++n) bs[bj][n] = *(const f32x4*)(base + off + bj * HALF + n * 16);
#pragma unroll
                for (int bj = 0; bj < 2; ++bj)
#pragma unroll
                    for (int n = 0; n < 2; ++n) *(f32x4*)(out + off + bj * HALF + n * 16) = bs[bj][n] + acc[ai][bj][m][n];
                if (m & 1) asm volatile("" ::: "memory"); }
    }
};
struct EpiResNorm {
    static constexpr bool PERM = true, POST = false;
    const float* base; float* out; const float* g; bf16_t* H; float* ss; int ldc;
    __device__ __forceinline__ void operator()(const f32x4 (&acc)[2][2][4][2], const Unit& u, int wr, int wc, int fr, int fq) const {
        const int row0 = u.pm * BM + wr * 64 + fr, col0 = u.pn * BM + wc * 32 + 8 * fq;
        f32x4 gv[2][2];
#pragma unroll
        for (int bj = 0; bj < 2; ++bj)
#pragma unroll
            for (int n = 0; n < 2; ++n) gv[bj][n] = *(const f32x4*)(g + col0 + bj * HALF + 4 * n);
#pragma unroll
        for (int ai = 0; ai < 2; ++ai)
#pragma unroll
            for (int m = 0; m < 4; ++m) { const int row = row0 + ai * HALF + m * 16; const size_t off = (size_t)row * ldc + col0;
                f32x4 x[2][2]; float s = 0.f;
#pragma unroll
                for (int bj = 0; bj < 2; ++bj)
#pragma unroll
                    for (int n = 0; n < 2; ++n) x[bj][n] = *(const f32x4*)(base + off + bj * HALF + 4 * n);
#pragma unroll
                for (int bj = 0; bj < 2; ++bj) {
#pragma unroll
                    for (int n = 0; n < 2; ++n) { x[bj][n] = x[bj][n] + acc[ai][bj][m][n]; *(f32x4*)(out + off + bj * HALF + 4 * n) = x[bj][n];
                        s += (x[bj][n][0] * x[bj][n][0] + x[bj][n][1] * x[bj][n][1]) + (x[bj][n][2] * x[bj][n][2] + x[bj][n][3] * x[bj][n][3]); }
                    const f32x4 h0 = x[bj][0] * gv[bj][0], h1 = x[bj][1] * gv[bj][1];
                    u32x4 w; w.x = cvt_pk_bf16(h0[0], h0[1]); w.y = cvt_pk_bf16(h0[2], h0[3]); w.z = cvt_pk_bf16(h1[0], h1[1]); w.w = cvt_pk_bf16(h1[2], h1[3]);
                    *(u32x4*)(H + off + bj * HALF) = w; }
                s += __shfl_xor(s, 16); s += __shfl_xor(s, 32);
                if (fq == 0) atomicAdd(ss + row, s);
                if (m & 1) asm volatile("" ::: "memory"); }
    }
};
struct EpiBf16Rs {
    static constexpr bool PERM = true, POST = false;
    bf16_t* O; int ldc; const float* ss; float inv_n;
    __device__ __forceinline__ void operator()(const f32x4 (&acc)[2][2][4][2], const Unit& u, int wr, int wc, int fr, int fq) const {
        const int row0 = u.pm * BM + wr * 64 + fr, col0 = u.pn * BM + wc * 32 + 8 * fq;
#pragma unroll
        for (int ai = 0; ai < 2; ++ai)
#pragma unroll
            for (int m = 0; m < 4; ++m) { const int row = row0 + ai * HALF + m * 16; bf16_t* rowp = O + (size_t)row * ldc + col0;
                const float rs = __builtin_amdgcn_rsqf(ss[row] * inv_n + EPS);
#pragma unroll
                for (int bj = 0; bj < 2; ++bj) { const f32x4 v0 = acc[ai][bj][m][0] * rs, v1 = acc[ai][bj][m][1] * rs;
                    u32x4 w; w.x = cvt_pk_bf16(v0[0], v0[1]); w.y = cvt_pk_bf16(v0[2], v0[3]); w.z = cvt_pk_bf16(v1[0], v1[1]); w.w = cvt_pk_bf16(v1[2], v1[3]);
                    *(u32x4*)(rowp + bj * HALF) = w; } }
    }
};
struct EpiKv {
    static constexpr bool PERM = true, POST = true;
    unsigned char* wsb; const float* gk;
    static constexpr int ldc = 2048; static constexpr float inv_n = 1.f / 256;
#define O ((bf16_t*)(wsb + WS_KVR))
#define ss ((const float*)(wsb + WS_SSQKV))
#define Z ((const bf16_t*)(wsb + WS_Z))
#define rt ((const float2*)(wsb + WS_ROPE))
#define KF ((bf16_t*)(wsb + WS_KF))
    __device__ __forceinline__ void operator()(const f32x4 (&acc)[2][2][4][2], const Unit& u, int wr, int wc, int fr, int fq) const {
        const int row0 = u.pm * BM + wr * 64 + fr, col0 = u.pn * BM + wc * 32 + 8 * fq;
#pragma unroll
        for (int ai = 0; ai < 2; ++ai)
#pragma unroll
            for (int m = 0; m < 4; ++m) { const int row = row0 + ai * HALF + m * 16; bf16_t* rowp = O + (size_t)row * ldc + col0;
                const float rs = __builtin_amdgcn_rsqf(ss[row] * inv_n + EPS);
#pragma unroll
                for (int bj = 0; bj < 2; ++bj) { const f32x4 v0 = acc[ai][bj][m][0] * rs, v1 = acc[ai][bj][m][1] * rs;
                    u32x4 w; w.x = cvt_pk_bf16(v0[0], v0[1]); w.y = cvt_pk_bf16(v0[2], v0[3]); w.z = cvt_pk_bf16(v1[0], v1[1]); w.w = cvt_pk_bf16(v1[2], v1[3]);
                    *(u32x4*)(rowp + bj * HALF) = w; } }
    }
    __device__ __forceinline__ void post(const Unit& u, int tid_in) const {
        int tid = tid_in; asm volatile("" : "+v"(tid));
        const int j = tid & 7, h = u.pn;
#pragma unroll 1
        for (int ps = 0; ps < 4; ++ps) {
            const int row = u.pm * BM + (tid >> 3) + 64 * ps; const int pos = row & (SEQ - 1);
            const bf16_t* kp = O + (size_t)row * ldc + h * 256 + j * 8;
            const u32x4 w0 = *(const u32x4*)kp, w1 = *(const u32x4*)(kp + 64), w2 = *(const u32x4*)(Z + (size_t)row * ZC + C_KR + j * 8);
            const f32x4* r4 = (const f32x4*)(rt + (size_t)pos * 32 + (j & 3) * 8);
            const f32x4 r0 = r4[0], r1 = r4[1], r2 = r4[2], r3 = r4[3];
            float v[24];
            unpack8(w0, v); unpack8(w1, v + 8); unpack8(w2, v + 16);
            float s2 = 0.f;
#pragma unroll
            for (int e = 0; e < 24; ++e) s2 += v[e] * v[e];
            s2 += __shfl_xor(s2, 1); s2 += __shfl_xor(s2, 2); s2 += __shfl_xor(s2, 4);
            const float rstd = __builtin_amdgcn_rsqf(s2 * (1.f / 192) + EPS);
#pragma unroll
            for (int c = 0; c < 3; ++c) { const f32x4 ga = *(const f32x4*)(gk + c * 64 + j * 8), gb = *(const f32x4*)(gk + c * 64 + j * 8 + 4);
                v[c * 8 + 0] *= rstd * ga.x; v[c * 8 + 1] *= rstd * ga.y; v[c * 8 + 2] *= rstd * ga.z; v[c * 8 + 3] *= rstd * ga.w;
                v[c * 8 + 4] *= rstd * gb.x; v[c * 8 + 5] *= rstd * gb.y; v[c * 8 + 6] *= rstd * gb.z; v[c * 8 + 7] *= rstd * gb.w; }
            const float cs[8] = {r0.x, r0.z, r1.x, r1.z, r2.x, r2.z, r3.x, r3.z}, sn[8] = {r0.y, r0.w, r1.y, r1.w, r2.y, r2.w, r3.y, r3.w};
#pragma unroll
            for (int e = 0; e < 8; ++e) { const float own = v[16 + e], oth = __shfl_xor(own, 4);
                v[16 + e] = (j < 4) ? (own * cs[e] - oth * sn[e]) : (own * cs[e] + oth * sn[e]); }
            bf16_t* op = KF + (size_t)row * 1536 + h * 192 + j * 8;
            *(u32x4*)op = pack8f(v); *(u32x4*)(op + 64) = pack8f(v + 8); *(u32x4*)(op + 128) = pack8f(v + 16);
        }
    }
};
#undef O
#undef ss
#undef Z
#undef rt
#undef KF
struct EpiGlu {
    static constexpr bool PERM = true, POST = false;
    const bf16_t* G; const float* cw; const float* cb; bf16_t* O; const float* ss;
    __device__ __forceinline__ void operator()(const f32x4 (&acc)[2][2][4][2], const Unit& u, int wr, int wc, int fr, int fq) const {
        const int row0 = u.pm * BM + wr * 64 + fr;
#pragma unroll
        for (int bj = 0; bj < 2; ++bj) {
            const int col0 = u.pn * BM + bj * HALF + wc * 32 + 8 * fq;
            float w0[8], w1[8], w2[8], b[8];
#pragma unroll
            for (int e = 0; e < 8; e += 4) {
                *(f32x4*)(w0 + e) = *(const f32x4*)(cw + col0 + e); *(f32x4*)(w1 + e) = *(const f32x4*)(cw + DFF + col0 + e);
                *(f32x4*)(w2 + e) = *(const f32x4*)(cw + 2 * DFF + col0 + e); *(f32x4*)(b + e) = *(const f32x4*)(cb + col0 + e); }
#pragma unroll
            for (int ai = 0; ai < 2; ++ai) {
#pragma unroll
              for (int mp = 0; mp < 4; mp += 2) {
                u32x4 g0[4], g1[4], g2[4]; float rs[4];
#pragma unroll
                for (int m = mp; m < mp + 2; ++m) {
                    const int row = row0 + ai * HALF + m * 16; const int tpos = row & (SEQ - 1);
                    const bf16_t* gp = G + (size_t)row * DFF + col0;
                    g2[m] = *(const u32x4*)gp;
                    const bool edge = (ai == 0 && m == 0);
                    g1[m] = *(const u32x4*)(gp - ((!edge || tpos >= 1) ? DFF : 0));
                    g0[m] = *(const u32x4*)(gp - ((!edge || tpos >= 2) ? 2 * DFF : 0));
                    rs[m] = ss[row];
                }
#pragma unroll
                for (int m = mp; m < mp + 2; ++m) {
                    const int row = row0 + ai * HALF + m * 16; const int tpos = row & (SEQ - 1);
                    const u32x4 z4 = {0u, 0u, 0u, 0u};
                    float f0[8], f1[8], f2[8], o[8];
                    const bool edge = (ai == 0 && m == 0);
                    unpack8((!edge || tpos >= 2) ? g0[m] : z4, f0); unpack8((!edge || tpos >= 1) ? g1[m] : z4, f1); unpack8(g2[m], f2);
                    const float r = __builtin_amdgcn_rsqf(rs[m] * (1.f / DM) + EPS);
                    const f32x4 v0 = acc[ai][bj][m][0] * r, v1 = acc[ai][bj][m][1] * r;
                    const float uu[8] = {v0[0], v0[1], v0[2], v0[3], v1[0], v1[1], v1[2], v1[3]};
#pragma unroll
                    for (int e = 0; e < 8; ++e) { const float gc = b[e] + w0[e] * f0[e] + w1[e] * f1[e] + w2[e] * f2[e];
                        const float sg = __builtin_amdgcn_rcpf(1.0f + __builtin_amdgcn_exp2f(-gc * 1.4426950408889634f));
                        o[e] = gc * sg * uu[e]; }
                    u32x4 w; w.x = cvt_pk_bf16(o[0], o[1]); w.y = cvt_pk_bf16(o[2], o[3]); w.z = cvt_pk_bf16(o[4], o[5]); w.w = cvt_pk_bf16(o[6], o[7]);
                    *(u32x4*)(O + (size_t)row * DFF + col0) = w;
                }
                asm volatile("" ::: "memory");
              }
            }
        }
    }
};

#ifndef PG8_SP2
#define PG8_SP2 true
#endif
template <class Epi, class Sched, bool SP2 = PG8_SP2>
__device__ __forceinline__ void gemm_phase(LAS unsigned char* lds, const Gemm g, const Sched& S, const Epi& E) {
    const int tid = threadIdx.x, wid = __builtin_amdgcn_readfirstlane(tid >> 6), lane = tid & 63, wr = wid >> 2, wc = wid & 3, fr = lane & 15, fq = lane >> 4;
    const int K = g.K, nt = K / BK, lda = g.lda;
    unsigned voffA[2], voffB[2];
#pragma unroll
    for (int i = 0; i < 2; ++i) { int R, C; stage_rc(tid * 16 + i * 8192, R, C); const int Rb = Epi::PERM ? ((R & ~31) + perm32(R & 31)) : R;
        voffA[i] = (unsigned)(R * lda + C) * 2u; voffB[i] = (unsigned)(Rb * K + C) * 2u; }
    const size_t kstep = (size_t)(BK * 2);
    const size_t hstepA = (size_t)HALF * lda * 2, hstepB = (size_t)HALF * K * 2;
    const size_t tstepA = 2 * hstepA, tstepB = 2 * hstepB;
    const unsigned ldsw = (unsigned)wid * 1024u;
    const int aoff = lds_byte(wr * 64 + fr, fq * 8), boff = lds_byte(wc * 32 + fr, fq * 8);
#define PG8_SA(b, h) (((b) * 2 + (h)) * HTB)
#define PG8_SB(b, h) ((4 + (b) * 2 + (h)) * HTB)
#define PG8_STAGE(bufoff, gbase, voff) do { _Pragma("unroll") for (int _i = 0; _i < 2; ++_i) \
        __builtin_amdgcn_global_load_lds((const unsigned*)((const char*)(gbase) + (voff)[_i]), (LAS unsigned*)(lds + (bufoff) + ldsw + _i * 8192), 16, 0, 0); } while (0)
#define PG8_LDA(dst, b, h) do { _Pragma("unroll") for (int m = 0; m < 4; ++m) _Pragma("unroll") for (int k = 0; k < 2; ++k) dst[m][k] = *(const LAS bf16x8*)(lds + PG8_SA(b, h) + aoff + m * 2048 + k * 1024); } while (0)
#define PG8_LDB(dst, b, h) do { _Pragma("unroll") for (int n = 0; n < 2; ++n) _Pragma("unroll") for (int k = 0; k < 2; ++k) dst[n][k] = *(const LAS bf16x8*)(lds + PG8_SB(b, h) + boff + n * 2048 + k * 1024); } while (0)
#define PG8_MMA(ai, bj, At, Bt) do { __builtin_amdgcn_s_setprio(1); _Pragma("unroll") for (int m = 0; m < 4; ++m) _Pragma("unroll") for (int n = 0; n < 2; ++n) _Pragma("unroll") for (int k = 0; k < 2; ++k) \
        acc[ai][bj][m][n] = __builtin_amdgcn_mfma_f32_16x16x32_bf16(Bt[n][k], At[m][k], acc[ai][bj][m][n], 0, 0, 0); __builtin_amdgcn_s_setprio(0); } while (0)
#define PG8_WAIT_V(n) asm volatile("s_waitcnt vmcnt(" #n ")" ::: "memory")
#define PG8_WAIT_L(n) asm volatile("s_waitcnt lgkmcnt(" #n ")" ::: "memory")
#define PG8_BAR __builtin_amdgcn_s_barrier()
#define PG8_SCHED __builtin_amdgcn_sched_barrier(0)
    Unit cur, nxt; int ui = 0;
    if (!S.next(0, cur)) return;
    f32x4 acc[2][2][4][2];
#pragma unroll
    for (int a = 0; a < 2; ++a)
#pragma unroll
        for (int b = 0; b < 2; ++b)
#pragma unroll
            for (int m = 0; m < 4; ++m)
#pragma unroll
                for (int n = 0; n < 2; ++n) acc[a][b][m][n] = (f32x4){0.f, 0.f, 0.f, 0.f};
    bf16x8 At[4][2], B0[2][2], B1[2][2];
    const char* cA = (const char*)g.A + (size_t)cur.pm * tstepA; const char* cB = (const char*)g.Bt + (size_t)cur.pn * tstepB;
    if constexpr (SP2) {
    PG8_STAGE(PG8_SB(0, 0), cB, voffB); PG8_STAGE(PG8_SB(0, 1), cB + hstepB, voffB); PG8_STAGE(PG8_SA(0, 0), cA, voffA); PG8_STAGE(PG8_SA(0, 1), cA + hstepA, voffA);
    if (wr == 1) PG8_BAR;
    PG8_WAIT_V(2); PG8_BAR;
    PG8_STAGE(PG8_SB(1, 0), cB + kstep, voffB); PG8_STAGE(PG8_SA(1, 0), cA + kstep, voffA); PG8_STAGE(PG8_SB(1, 1), cB + hstepB + kstep, voffB);
    PG8_WAIT_V(6); PG8_BAR;
    } else {
    PG8_STAGE(PG8_SB(0, 0), cB, voffB); PG8_STAGE(PG8_SA(0, 0), cA, voffA); PG8_STAGE(PG8_SB(0, 1), cB + hstepB, voffB); PG8_STAGE(PG8_SA(0, 1), cA + hstepA, voffA);
    if (wr == 1) PG8_BAR;
    PG8_WAIT_V(4); PG8_BAR;
    PG8_STAGE(PG8_SB(1, 0), cB + kstep, voffB); PG8_STAGE(PG8_SA(1, 0), cA + kstep, voffA); PG8_STAGE(PG8_SB(1, 1), cB + hstepB + kstep, voffB);
    PG8_WAIT_V(6); PG8_BAR;
    }
    for (;;) {
        const bool has_next = S.next(ui + 1, nxt);
        const char* nA = has_next ? (const char*)g.A + (size_t)nxt.pm * tstepA : cA; const char* nB = has_next ? (const char*)g.Bt + (size_t)nxt.pn * tstepB : cB;
        for (int t = 0; t < nt; t += 2) {
            const bool last = (t == nt - 2);
            const char* a1 = cA + (size_t)(t + 1) * kstep;
            const char* a2 = last ? nA : cA + (size_t)(t + 2) * kstep; const char* b2 = last ? nB : cB + (size_t)(t + 2) * kstep;
            const char* a3 = a2 + kstep; const char* b3 = b2 + kstep;
            if constexpr (SP2) {
            PG8_LDB(B0, 0, 0); PG8_LDB(B1, 0, 1); PG8_SCHED; PG8_LDA(At, 0, 0); PG8_STAGE(PG8_SA(1, 1), a1 + hstepA, voffA);
            PG8_WAIT_V(8); PG8_WAIT_L(0); PG8_BAR; PG8_MMA(0, 0, At, B0); PG8_MMA(0, 1, At, B1); PG8_BAR; PG8_SCHED;
            PG8_LDA(At, 0, 1); PG8_STAGE(PG8_SB(0, 0), b2, voffB); PG8_STAGE(PG8_SB(0, 1), b2 + hstepB, voffB); PG8_STAGE(PG8_SA(0, 0), a2, voffA);
            PG8_WAIT_V(8); PG8_WAIT_L(0); PG8_BAR; PG8_MMA(1, 0, At, B0); PG8_MMA(1, 1, At, B1); PG8_BAR; PG8_SCHED;
            PG8_LDB(B0, 1, 0); PG8_LDB(B1, 1, 1); PG8_SCHED; PG8_LDA(At, 1, 0); PG8_STAGE(PG8_SA(0, 1), a2 + hstepA, voffA);
            PG8_WAIT_V(8); PG8_WAIT_L(0); PG8_BAR; PG8_MMA(0, 0, At, B0); PG8_MMA(0, 1, At, B1); PG8_BAR; PG8_SCHED;
            PG8_LDA(At, 1, 1); PG8_STAGE(PG8_SB(1, 0), b3, voffB); PG8_STAGE(PG8_SB(1, 1), b3 + hstepB, voffB); PG8_STAGE(PG8_SA(1, 0), a3, voffA);
            PG8_WAIT_V(8); PG8_WAIT_L(0); PG8_BAR; PG8_MMA(1, 0, At, B0); PG8_MMA(1, 1, At, B1); PG8_BAR; PG8_SCHED;
            } else {
            PG8_LDB(B0, 0, 0); PG8_SCHED; PG8_LDA(At, 0, 0); PG8_STAGE(PG8_SA(1, 1), a1 + hstepA, voffA);
            PG8_WAIT_L(8); PG8_BAR; PG8_WAIT_L(0); PG8_MMA(0, 0, At, B0); PG8_BAR; PG8_SCHED;
            PG8_LDB(B1, 0, 1); PG8_STAGE(PG8_SB(0, 0), b2, voffB);
            PG8_BAR; PG8_WAIT_L(0); PG8_MMA(0, 1, At, B1); PG8_BAR;
            PG8_LDA(At, 0, 1); PG8_STAGE(PG8_SA(0, 0), a2, voffA);
            PG8_BAR; PG8_WAIT_L(0); PG8_MMA(1, 0, At, B0); PG8_BAR; PG8_SCHED;
            PG8_STAGE(PG8_SB(0, 1), b2 + hstepB, voffB);
            PG8_WAIT_V(6); PG8_BAR; PG8_MMA(1, 1, At, B1); PG8_BAR;
            PG8_LDB(B0, 1, 0); PG8_SCHED; PG8_LDA(At, 1, 0); PG8_STAGE(PG8_SA(0, 1), a2 + hstepA, voffA);
            PG8_WAIT_L(8); PG8_BAR; PG8_WAIT_L(0); PG8_MMA(0, 0, At, B0); PG8_BAR; PG8_SCHED;
            PG8_LDB(B1, 1, 1); PG8_STAGE(PG8_SB(1, 0), b3, voffB);
            PG8_BAR; PG8_WAIT_L(0); PG8_MMA(0, 1, At, B1); PG8_BAR;
            PG8_LDA(At, 1, 1); PG8_STAGE(PG8_SA(1, 0), a3, voffA);
            PG8_BAR; PG8_WAIT_L(0); PG8_MMA(1, 0, At, B0); PG8_BAR; PG8_SCHED;
            PG8_STAGE(PG8_SB(1, 1), b3 + hstepB, voffB);
            PG8_WAIT_V(6); PG8_BAR; PG8_MMA(1, 1, At, B1); PG8_BAR;
            }
        }
        if (wr == 0) PG8_BAR;
        E(acc, cur, wr, wc, fr, fq);
        if constexpr (Epi::POST) { asm volatile("s_waitcnt vmcnt(0)" ::: "memory"); PG8_BAR; asm volatile("" ::: "memory"); E.post(cur, tid); }
        if (!has_next) break;
#pragma unroll
        for (int a = 0; a < 2; ++a)
#pragma unroll
            for (int b = 0; b < 2; ++b)
#pragma unroll
                for (int m = 0; m < 4; ++m)
#pragma unroll
                    for (int n = 0; n < 2; ++n) acc[a][b][m][n] = (f32x4){0.f, 0.f, 0.f, 0.f};
        cur = nxt; cA = nA; cB = nB; ++ui;
        if (wr == 1) PG8_BAR;
    }
    PG8_WAIT_V(0);
    PG8_BAR;
#undef PG8_SA
#undef PG8_SB
#undef PG8_STAGE
#undef PG8_LDA
#undef PG8_LDB
#undef PG8_MMA
#undef PG8_WAIT_V
#undef PG8_WAIT_L
#undef PG8_BAR
#undef PG8_SCHED
}
}

namespace att {
constexpr int NW = 8, QBLK = 32, KVBLK = 64, QB = NW * QBLK, DV = 128;
constexpr int SHM_V = KVBLK * DV * 2;
#define SBAR() __builtin_amdgcn_sched_barrier(0)
__device__ __forceinline__ int v_st(int k, int c) { const int kk = (k & ~0xC) | ((k & 4) << 1) | ((k & 8) >> 1); return ((kk >> 3) * 4 + (c >> 5)) * 512 + ((kk & 7) * 32 + (c & 31)) * 2; }
__device__ __forceinline__ int v_rd_base(int lane) { return ((lane & 3) << 3) | (((lane >> 2) & 3) << 6) | (((lane >> 4) & 1) << 5) | (((lane >> 5) & 1) << 8); }
constexpr int v_rd_off(int d0, int ks, int half) { return d0 * 512 + ks * 4096 + half * 2048; }
__device__ __forceinline__ int crow(int r, int hi) { return (r & 3) + 8 * (r >> 2) + 4 * hi; }
__device__ __forceinline__ bf16x8 load8(const bf16_t* p) { return *reinterpret_cast<const bf16x8*>(p); }

__device__ __forceinline__ void mask_tile(f32x16& p0, f32x16& p1, int dq) {
    const float NEG = -__builtin_inff();
#pragma unroll
    for (int r = 0; r < 16; ++r) {
        const int c = (r & 3) + 8 * (r >> 2);
        if (dq - c < 0) p0[r] = NEG;
        if (dq - c - 32 < 0) p1[r] = NEG;
    }
}
constexpr float THR = 8.f;
__device__ __forceinline__ void partialSM(f32x16& p0, f32x16& p1, float& m_reg, float& mn, float& alpha, float SCALE) {
    float pmax = p0[0];
#pragma unroll
    for (int r = 1; r < 16; ++r) pmax = fmaxf(pmax, p0[r]);
#pragma unroll
    for (int r = 0; r < 16; ++r) pmax = fmaxf(pmax, p1[r]);
    { auto rr = __builtin_amdgcn_permlane32_swap(__float_as_uint(pmax), __float_as_uint(pmax), false, false);
      pmax = fmaxf(__uint_as_float(rr[0]), __uint_as_float(rr[1])); }
    const float C2 = 1.4426950408889634f * SCALE;
    if (__builtin_expect(__all((pmax - m_reg) * SCALE <= THR), 1)) { mn = m_reg; alpha = 1.f; }
    else { mn = fmaxf(m_reg, pmax); alpha = __builtin_amdgcn_exp2f((m_reg - mn) * C2); m_reg = mn; }
    const float mnL = -mn * C2;
#pragma unroll
    for (int r = 0; r < 16; ++r) p0[r] = fmaf(p0[r], C2, mnL);
#pragma unroll
    for (int r = 0; r < 16; ++r) p1[r] = fmaf(p1[r], C2, mnL);
#pragma unroll
    for (int r = 0; r < 16; ++r) p0[r] = __builtin_amdgcn_exp2f(p0[r]);
}
__device__ __forceinline__ void finishSM(f32x16& p0, f32x16& p1, float alpha, float& l_reg, bf16x8& pa0, bf16x8& pa1, bf16x8& pa2, bf16x8& pa3) {
#pragma unroll
    for (int r = 0; r < 16; ++r) p1[r] = __builtin_amdgcn_exp2f(p1[r]);
    float ps = 0;
#pragma unroll
    for (int r = 0; r < 16; ++r) ps += p0[r];
#pragma unroll
    for (int r = 0; r < 16; ++r) ps += p1[r];
    { auto rr = __builtin_amdgcn_permlane32_swap(__float_as_uint(ps), __float_as_uint(ps), false, false);
      ps = __uint_as_float(rr[0]) + __uint_as_float(rr[1]); }
    l_reg = l_reg * alpha + ps;
#define PK4(P, B_, OUT) do { unsigned a0 = cvt_pk_bf16(P[B_+0], P[B_+1]), a1 = cvt_pk_bf16(P[B_+2], P[B_+3]);                          \
        unsigned b0 = cvt_pk_bf16(P[B_+4], P[B_+5]), b1 = cvt_pk_bf16(P[B_+6], P[B_+7]);                                             \
        auto r0 = __builtin_amdgcn_permlane32_swap(a0, b0, false, false); auto r1 = __builtin_amdgcn_permlane32_swap(a1, b1, false, false); \
        u32x4 w = {r0[0], r1[0], r0[1], r1[1]}; OUT = *reinterpret_cast<bf16x8*>(&w); } while (0)
    PK4(p0, 0, pa0); PK4(p0, 8, pa1); PK4(p1, 0, pa2); PK4(p1, 8, pa3);
#undef PK4
}
template <int DQK_, int QS_, int KS_, int VS_, int OS_> struct Cfg {
    static constexpr float SCALE = DQK_ == 192 ? 0.07216878364870322f : 0.08838834764831845f;
    static constexpr int DQK = DQK_, QS = QS_, KS = KS_, VS = VS_, OS = OS_;
    static constexpr int RB = DQK * 2 + 16;
    static constexpr int SHM_K = KVBLK * RB;
    static constexpr int NQ = DQK / 16;
    static constexpr int NCH = DQK / 8;
    static constexpr int KST = DQK / 64;
    static constexpr int NQR = 8;
    static constexpr int QL_OFF = 2 * SHM_V + 2 * SHM_K + NW * 64 * 4;
};
#define KSWZ(C, row, colB) ((row) * C::RB + (colB))
template <class C, int KB>
__device__ __forceinline__ void qkt(f32x16& p0, f32x16& p1, const char* K_lds, int r32, int hi, const bf16x8* qr, const char* ql) {
    p0 = f32x16{}; p1 = f32x16{};
    const char* kb[4];
#pragma unroll
    for (int dd = 0; dd < 4; ++dd) kb[dd] = K_lds + KB * C::SHM_K + KSWZ(C, r32, (dd * 16 + hi * 8) * 2);
#pragma unroll
    for (int d0 = 0; d0 < C::NQ; ++d0) { const char* a = kb[d0 & 3] + (d0 >> 2) * 128;
        bf16x8 b0 = *reinterpret_cast<const bf16x8*>(a);
        bf16x8 b1 = *reinterpret_cast<const bf16x8*>(a + 32 * C::RB);
        bf16x8 qf; if (d0 < C::NQR) qf = qr[d0]; else qf = *reinterpret_cast<const bf16x8*>(ql + (d0 - C::NQR) * 1024);
        p0 = __builtin_amdgcn_mfma_f32_32x32x16_bf16(b0, qf, p0, 0, 0, 0);
        p1 = __builtin_amdgcn_mfma_f32_32x32x16_bf16(b1, qf, p1, 0, 0, 0);
        if ((d0 & 3) == 3 && d0 + 1 < C::NQ) SBAR(); }
}
template <int VB>
__device__ __forceinline__ void pv_tile(f32x16* o, int vb0, bf16x8 pa0, bf16x8 pa1, bf16x8 pa2, bf16x8 pa3) {
#define TRRD(dst, off) asm volatile("ds_read_b64_tr_b16 %0, %1 offset:%2" : "=&v"(dst) : "v"(vb0), "i"(off) : "memory")
#define PV_D0(d0) do { s16x4 l0, l1, l2, l3, h0, h1, h2, h3; constexpr int b_ = VB * SHM_V + v_rd_off(d0, 0, 0); \
        TRRD(l0, b_); TRRD(h0, b_ + 2048); TRRD(l1, b_ + 4096); TRRD(h1, b_ + 6144); TRRD(l2, b_ + 8192); TRRD(h2, b_ + 10240); TRRD(l3, b_ + 12288); TRRD(h3, b_ + 14336); \
        asm volatile("s_waitcnt lgkmcnt(0)" ::: "memory"); SBAR(); \
        o[d0] = __builtin_amdgcn_mfma_f32_32x32x16_bf16(pa0, (bf16x8){l0[0], l0[1], l0[2], l0[3], h0[0], h0[1], h0[2], h0[3]}, o[d0], 0, 0, 0);   \
        o[d0] = __builtin_amdgcn_mfma_f32_32x32x16_bf16(pa1, (bf16x8){l1[0], l1[1], l1[2], l1[3], h1[0], h1[1], h1[2], h1[3]}, o[d0], 0, 0, 0);   \
        o[d0] = __builtin_amdgcn_mfma_f32_32x32x16_bf16(pa2, (bf16x8){l2[0], l2[1], l2[2], l2[3], h2[0], h2[1], h2[2], h2[3]}, o[d0], 0, 0, 0);   \
        o[d0] = __builtin_amdgcn_mfma_f32_32x32x16_bf16(pa3, (bf16x8){l3[0], l3[1], l3[2], l3[3], h3[0], h3[1], h3[2], h3[3]}, o[d0], 0, 0, 0); } while (0)
    PV_D0(0); PV_D0(1); PV_D0(2); PV_D0(3);
#undef PV_D0
#undef TRRD
}
struct BlockRef { const bf16_t* Q; const bf16_t* K; const bf16_t* V; bf16_t* O; int P0; };
template <class C> struct Seam { bf16x8 qr[C::NQ]; bf16x8 st_v0, st_v1; bf16x8 st_k[C::KST]; };

#define VMW() asm volatile("s_waitcnt vmcnt(0)" ::: "memory")
#define VMWN(n) asm volatile("s_waitcnt vmcnt(%0)" :: "i"(n) : "memory")
#define SLOAD(Kp, Vp, k0) do { S.st_v0 = load8((Vp) + (size_t)((k0) + sr) * C::VS + sc); S.st_v1 = load8((Vp) + (size_t)((k0) + 32 + sr) * C::VS + sc); \
        const bf16_t* kp_ = (Kp) + (size_t)((k0) + (tid >> 3)) * C::KS + (tid & 7) * 8; \
        _Pragma("unroll") for (int i_ = 0; i_ < C::KST; ++i_) S.st_k[i_] = load8(kp_ + 64 * i_); } while (0)
#define SWRITE_K(bf) do { char* kw_ = K_lds + (bf) * C::SHM_K + (tid >> 3) * C::RB + (tid & 7) * 16; \
        _Pragma("unroll") for (int i_ = 0; i_ < C::KST; ++i_) *(bf16x8*)(kw_ + 128 * i_) = S.st_k[i_]; } while (0)
#define SWRITE_V(bf) do { *(bf16x8*)(V_lds + (bf) * SHM_V + vst0) = S.st_v0; *(bf16x8*)(V_lds + (bf) * SHM_V + vst1) = S.st_v1; } while (0)

#define KSRC(tt) (((tt) < NT) ? Kh + (size_t)(tt) * KVBLK * C::KS : nxt.K + (size_t)((tt) - NT) * KVBLK * C::KS)
#define VSRC(tt) (((tt) < NT) ? Vh + (size_t)(tt) * KVBLK * C::VS : nxt.V + (size_t)((tt) - NT) * KVBLK * C::VS)
template <class C>
__device__ __forceinline__ void qxform(Seam<C>& S, int pos, int hi, const float* gq, const float2* rt) {
    if constexpr (C::DQK == 192) {
        int ho = hi * 8; asm volatile("" : "+v"(ho));
        float ss = 0.f;
#pragma unroll
        for (int d0 = 0; d0 < 12; ++d0) { float f[8]; unpack8(__builtin_bit_cast(u32x4, S.qr[d0]), f);
#pragma unroll
            for (int e = 0; e < 8; ++e) ss += f[e] * f[e]; }
        { auto rr = __builtin_amdgcn_permlane32_swap(__float_as_uint(ss), __float_as_uint(ss), false, false); ss = __uint_as_float(rr[0]) + __uint_as_float(rr[1]); }
        const float rstd = __builtin_amdgcn_rsqf(ss * (1.f / 192) + EPS);
#pragma unroll
        for (int d0 = 0; d0 < 8; ++d0) { float f[8], g[8]; unpack8(__builtin_bit_cast(u32x4, S.qr[d0]), f);
            *(f32x4*)g = *(const f32x4*)(gq + d0 * 16 + ho); *(f32x4*)(g + 4) = *(const f32x4*)(gq + d0 * 16 + ho + 4);
#pragma unroll
            for (int e = 0; e < 8; ++e) f[e] = f[e] * rstd * g[e];
            S.qr[d0] = __builtin_bit_cast(bf16x8, pack8f(f)); __builtin_amdgcn_sched_barrier(0); }
#pragma unroll
        for (int d = 0; d < 2; ++d) { float fa[8], fb[8], ga[8], gb[8], cs[16];
            unpack8(__builtin_bit_cast(u32x4, S.qr[8 + d]), fa); unpack8(__builtin_bit_cast(u32x4, S.qr[10 + d]), fb);
            *(f32x4*)ga = *(const f32x4*)(gq + 128 + d * 16 + ho); *(f32x4*)(ga + 4) = *(const f32x4*)(gq + 128 + d * 16 + ho + 4);
            *(f32x4*)gb = *(const f32x4*)(gq + 160 + d * 16 + ho); *(f32x4*)(gb + 4) = *(const f32x4*)(gq + 160 + d * 16 + ho + 4);
            const f32x4* r4 = (const f32x4*)(rt + (size_t)pos * 32 + d * 16 + ho);
#pragma unroll
            for (int e = 0; e < 4; ++e) *(f32x4*)(cs + 4 * e) = r4[e];
#pragma unroll
            for (int e = 0; e < 8; ++e) { const float a = fa[e] * rstd * ga[e], b = fb[e] * rstd * gb[e], c = cs[2 * e], sn = cs[2 * e + 1];
                fa[e] = a * c - b * sn; fb[e] = b * c + a * sn; }
            S.qr[8 + d] = __builtin_bit_cast(bf16x8, pack8f(fa)); S.qr[10 + d] = __builtin_bit_cast(bf16x8, pack8f(fb)); __builtin_amdgcn_sched_barrier(0); }
    } else {
        int ho = hi * 8; asm volatile("" : "+v"(ho));
        float ss = 0.f;
#pragma unroll
        for (int d0 = 0; d0 < 8; ++d0) { float f[8]; unpack8(__builtin_bit_cast(u32x4, S.qr[d0]), f);
#pragma unroll
            for (int e = 0; e < 8; ++e) ss += f[e] * f[e]; }
        { auto rr = __builtin_amdgcn_permlane32_swap(__float_as_uint(ss), __float_as_uint(ss), false, false); ss = __uint_as_float(rr[0]) + __uint_as_float(rr[1]); }
        const float rstd = __builtin_amdgcn_rsqf(ss * (1.f / 128) + EPS);
#pragma unroll
        for (int d0 = 0; d0 < 8; ++d0) { float f[8], g[8]; unpack8(__builtin_bit_cast(u32x4, S.qr[d0]), f);
            *(f32x4*)g = *(const f32x4*)(gq + d0 * 16 + ho); *(f32x4*)(g + 4) = *(const f32x4*)(gq + d0 * 16 + ho + 4);
#pragma unroll
            for (int e = 0; e < 8; ++e) f[e] = f[e] * rstd * g[e];
            S.qr[d0] = __builtin_bit_cast(bf16x8, pack8f(f)); __builtin_amdgcn_sched_barrier(0); }
    }
}
template <class C>
__device__ __forceinline__ void prime(const BlockRef& cur, char* lds, Seam<C>& S) {
    int tid_ = threadIdx.x; asm volatile("" : "+v"(tid_));
    const int tid = tid_, wid = __builtin_amdgcn_readfirstlane(tid >> 6), lane = tid & 63, r32 = lane & 31, hi = lane >> 5;
    const int sr = tid >> 4, sc = (tid & 15) * 8, vst0 = v_st(sr, sc), vst1 = v_st(32 + sr, sc); char* V_lds = lds; char* K_lds = lds + 2 * SHM_V;
#pragma unroll
    for (int d0 = 0; d0 < C::NQ; ++d0) S.qr[d0] = load8(cur.Q + (size_t)(wid * QBLK + r32) * C::QS + d0 * 16 + hi * 8);
    SLOAD(cur.K, cur.V, 0); VMW(); SWRITE_K(0); SWRITE_V(0);
    SLOAD(cur.K, cur.V, KVBLK);
    __syncthreads();
}
template <class C>
__device__ __forceinline__ void block(const BlockRef& cur, const BlockRef& nxt, int skv, char* lds, Seam<C>& S, const float* gq, const float2* rt) {
    int tid_ = threadIdx.x; asm volatile("" : "+v"(tid_));
    const int tid = tid_, wid = __builtin_amdgcn_readfirstlane(tid >> 6), lane = tid & 63, r32 = lane & 31, hi = lane >> 5;
    int j_hi = (cur.P0 + QB - 1) / KVBLK + 1; if (j_hi > skv / KVBLK) j_hi = skv / KVBLK;
    const int NT = j_hi;
    const int qlo = cur.P0 + wid * QBLK, qm = qlo + r32 - 4 * hi;
    char* V_lds = lds; char* K_lds = lds + 2 * SHM_V;
    float* ws = (float*)(lds + 2 * SHM_V + 2 * C::SHM_K) + wid * 64; float* li_l = ws, * al_l = ws + 32;
    float m_reg = -1e30f, l_reg = 0; f32x16 o[4] = {};
    const int sr = tid >> 4, sc = (tid & 15) * 8, vst0 = v_st(sr, sc), vst1 = v_st(32 + sr, sc);
    const int vb0 = (int)(uintptr_t)V_lds + v_rd_base(lane);
    const bf16_t* Kh = cur.K; const bf16_t* Vh = cur.V;
    char* ql = lds + C::QL_OFF + wid * 4096 + lane * 16;
    qxform<C>(S, cur.P0 + wid * QBLK + r32, hi, gq, rt);
#pragma unroll
    for (int d0 = C::NQR; d0 < C::NQ; ++d0) *(bf16x8*)(ql + (d0 - C::NQR) * 1024) = S.qr[d0];
    constexpr float SCALE = C::SCALE, C2 = 1.4426950408889634f * C::SCALE;
#define TRRD1(dst, off) asm volatile("ds_read_b64_tr_b16 %0, %1 offset:%2" : "=&v"(dst) : "v"(vb0), "i"(off) : "memory")
#define TR_ISSUE(V, B, d0) do { constexpr int b_ = (B) * SHM_V + v_rd_off(d0, 0, 0); TRRD1(V[0], b_); TRRD1(V[1], b_ + 2048); TRRD1(V[2], b_ + 4096); TRRD1(V[3], b_ + 6144); \
        TRRD1(V[4], b_ + 8192); TRRD1(V[5], b_ + 10240); TRRD1(V[6], b_ + 12288); TRRD1(V[7], b_ + 14336); } while (0)
#define WAITL(n) do { asm volatile("s_waitcnt lgkmcnt(%0)" :: "i"(n) : "memory"); SBAR(); } while (0)
#define VF(V, k) (bf16x8){V[2*(k)][0], V[2*(k)][1], V[2*(k)][2], V[2*(k)][3], V[2*(k)+1][0], V[2*(k)+1][1], V[2*(k)+1][2], V[2*(k)+1][3]}
#define PV_MMA(V, d0) do { o[d0] = __builtin_amdgcn_mfma_f32_32x32x16_bf16(pa0, VF(V, 0), o[d0], 0, 0, 0); o[d0] = __builtin_amdgcn_mfma_f32_32x32x16_bf16(pa1, VF(V, 1), o[d0], 0, 0, 0); \
        o[d0] = __builtin_amdgcn_mfma_f32_32x32x16_bf16(pa2, VF(V, 2), o[d0], 0, 0, 0); o[d0] = __builtin_amdgcn_mfma_f32_32x32x16_bf16(pa3, VF(V, 3), o[d0], 0, 0, 0); SBAR(); } while (0)
#define STEP(t, B) do { f32x16 p0, p1; bf16x8 pa0, pa1, pa2, pa3; float alpha;                                             \
        SBAR(); qkt<C, B>(p0, p1, K_lds, r32, hi, S.qr, ql); SBAR();                                                       \
        s16x4 vA_[8], vB_[8]; TR_ISSUE(vA_, B, 0);                                                                         \
        if ((t) == NT - 1) { _Pragma("unroll") for (int d0 = 0; d0 < C::NQ; ++d0) S.qr[d0] = load8(nxt.Q + (size_t)(wid * QBLK + r32) * C::QS + d0 * 16 + hi * 8); } \
        { const int kb_ = (t) * KVBLK; if (kb_ + KVBLK - 1 > qlo) mask_tile(p0, p1, qm - kb_); }                           \
        { float pmax = p0[0];                                                                                              \
          _Pragma("unroll") for (int r = 1; r < 16; ++r) pmax = fmaxf(pmax, p0[r]);                                        \
          _Pragma("unroll") for (int r = 0; r < 16; ++r) pmax = fmaxf(pmax, p1[r]);                                        \
          { auto rr = __builtin_amdgcn_permlane32_swap(__float_as_uint(pmax), __float_as_uint(pmax), false, false);        \
            pmax = fmaxf(__uint_as_float(rr[0]), __uint_as_float(rr[1])); }                                                \
          float mn;                                                                                                        \
          if (__builtin_expect(__all((pmax - m_reg) * SCALE <= THR), 1)) { mn = m_reg; alpha = 1.f; }                      \
          else { mn = fmaxf(m_reg, pmax); alpha = __builtin_amdgcn_exp2f((m_reg - mn) * C2); m_reg = mn; }                 \
          const float mnL = -mn * C2;                                                                                      \
          _Pragma("unroll") for (int r = 0; r < 16; ++r) p0[r] = __builtin_amdgcn_exp2f(fmaf(p0[r], C2, mnL));             \
          _Pragma("unroll") for (int r = 0; r < 16; ++r) p1[r] = __builtin_amdgcn_exp2f(fmaf(p1[r], C2, mnL));             \
          float ps = 0;                                                                                                    \
          _Pragma("unroll") for (int r = 0; r < 16; ++r) ps += p0[r];                                                      \
          _Pragma("unroll") for (int r = 0; r < 16; ++r) ps += p1[r];                                                      \
          { auto rr = __builtin_amdgcn_permlane32_swap(__float_as_uint(ps), __float_as_uint(ps), false, false);            \
            ps = __uint_as_float(rr[0]) + __uint_as_float(rr[1]); }                                                        \
          l_reg = l_reg * alpha + ps; }                                                                                    \
        PK4(p0, 0, pa0); PK4(p0, 8, pa1); PK4(p1, 0, pa2); PK4(p1, 8, pa3);                                                \
        if (__any(alpha < 1.f)) { if (hi == 0) al_l[r32] = alpha; asm volatile("s_waitcnt lgkmcnt(0)" ::: "memory");       \
            _Pragma("unroll") for (int d_ = 0; d_ < 4; ++d_) _Pragma("unroll") for (int r = 0; r < 16; ++r) o[d_][r] *= al_l[crow(r, hi)]; } \
        SBAR(); TR_ISSUE(vB_, B, 1); WAITL(8); PV_MMA(vA_, 0); TR_ISSUE(vA_, B, 2); WAITL(8); PV_MMA(vB_, 1);                \
        TR_ISSUE(vB_, B, 3); WAITL(8); PV_MMA(vA_, 2); WAITL(0); PV_MMA(vB_, 3); SBAR();                                     \
        VMW(); SWRITE_K((B) ^ 1); SWRITE_V((B) ^ 1);                                                                       \
        __syncthreads();                                                                                                   \
        SLOAD(KSRC((t) + 2), VSRC((t) + 2), 0); } while (0)
#define PK4(P, B_, OUT) do { unsigned a0 = cvt_pk_bf16(P[B_+0], P[B_+1]), a1 = cvt_pk_bf16(P[B_+2], P[B_+3]);                          \
        unsigned b0 = cvt_pk_bf16(P[B_+4], P[B_+5]), b1 = cvt_pk_bf16(P[B_+6], P[B_+7]);                                             \
        auto r0 = __builtin_amdgcn_permlane32_swap(a0, b0, false, false); auto r1 = __builtin_amdgcn_permlane32_swap(a1, b1, false, false); \
        u32x4 w = {r0[0], r1[0], r0[1], r1[1]}; OUT = *reinterpret_cast<bf16x8*>(&w); } while (0)
    for (int t = 0; t < NT; t += 2) { STEP(t, 0); STEP(t + 1, 1); }
#undef STEP
#undef PK4
#undef TRRD1
#undef TR_ISSUE
#undef WAITL
#undef VF
#undef PV_MMA
    if (hi == 0) li_l[r32] = l_reg; asm volatile("s_waitcnt lgkmcnt(0)" ::: "memory");
    float rli[16];
#pragma unroll
    for (int r = 0; r < 16; ++r) rli[r] = __builtin_amdgcn_rcpf(li_l[crow(r, hi)]);
    bf16_t* Ow = cur.O + (size_t)(wid * QBLK) * C::OS;
#pragma unroll
    for (int r = 0; r < 16; ++r) { const int orow = crow(r, hi);
#pragma unroll
        for (int d0 = 0; d0 < 4; ++d0) { const float v = o[d0][r] * rli[r];
            const float vn = __shfl_xor(v, 1);
            if ((r32 & 1) == 0) *(unsigned*)(Ow + (size_t)orow * C::OS + d0 * 32 + r32) = cvt_pk_bf16(v, vn); } }
    asm volatile("s_waitcnt lgkmcnt(0)" ::: "memory");
}
#undef KSRC
#undef VSRC
#undef VMW
#undef VMWN
#undef SLOAD
#undef SWRITE_K
#undef SWRITE_V
#undef SBAR
}


#define XB_TMO      128
#define XB_XCNT(j)  (256  + 64 * (j))
#define XB_XSUB(j)  (1280 + 64 * (j))
#define XB_XGEN(j)  (2304 + 64 * (j))
#define XB_TOP      3328
#define XB_TOPGEN   3392
#define XCD_BAR_WORDS 3456
#define XB_SPIN_CAP (1u << 22)
__device__ __forceinline__ unsigned xb_ld(unsigned* p)              { return __hip_atomic_load(p, __ATOMIC_RELAXED, __HIP_MEMORY_SCOPE_AGENT); }
__device__ __forceinline__ unsigned xb_add(unsigned* p, unsigned v) { return __hip_atomic_fetch_add(p, v, __ATOMIC_RELAXED, __HIP_MEMORY_SCOPE_AGENT); }
__device__ __forceinline__ unsigned xb_xcc_id() { return (unsigned)__builtin_amdgcn_s_getreg((3 << 11) | 20) & 0xFu; }
#define XB_SPIN(cond, bar) do { unsigned _sp = 0; while (cond) { __builtin_amdgcn_s_sleep(1); \
    if ((++_sp & 255u) == 0u) { if (xb_ld(&(bar)[XB_TMO])) break; if (_sp > XB_SPIN_CAP) { atomicAdd(&(bar)[XB_TMO], 1u); break; } } } } while (0)
struct XcdBarrier { unsigned* bar; unsigned x; volatile LAS unsigned* st; };
__device__ __forceinline__ XcdBarrier xcd_barrier_post(unsigned* bar, volatile LAS unsigned* st) {
    XcdBarrier b; b.bar = bar; b.x = xb_xcc_id(); b.st = st;
    if (threadIdx.x == 0) (void)xb_add(&bar[XB_XCNT(b.x)], 1u);
    return b;
}
__device__ __forceinline__ void xcd_barrier_complete(unsigned* bar, unsigned x, unsigned& nloc, unsigned& nx) {
    const unsigned G = gridDim.x * gridDim.y * gridDim.z;
    unsigned sum, cnt, mine, sp = 0u;
    for (;;) {
        sum = 0u; cnt = 0u; mine = 0u;
#pragma unroll
        for (unsigned j = 0; j < 16; ++j) { const unsigned c = xb_ld(&bar[XB_XCNT(j)]); sum += c; cnt += (c > 0u) ? 1u : 0u; mine = (j == x) ? c : mine; }
        if (sum == G) break;
        __builtin_amdgcn_s_sleep(1);
        if ((++sp & 255u) == 0u) { if (xb_ld(&bar[XB_TMO])) break; if (sp > XB_SPIN_CAP) { atomicAdd(&bar[XB_TMO], 1u); break; } }
    }
    nloc = mine > 0u ? mine : 1u; nx = cnt > 0u ? cnt : 1u;
}
__device__ __forceinline__ void xcd_barrier(const XcdBarrier& b) {
    asm volatile("s_waitcnt vmcnt(0)" ::: "memory");
    __syncthreads();
    if (threadIdx.x == 0) {
        unsigned* bar = b.bar;
        __builtin_amdgcn_s_waitcnt(0);
        unsigned nloc = b.st[0], nx = b.st[1];
        if (nloc == 0u) { xcd_barrier_complete(bar, b.x, nloc, nx); b.st[0] = nloc; b.st[1] = nx; }
        const unsigned old = xb_add(&bar[XB_XSUB(b.x)], 1u);
        const unsigned gen = old / nloc;
        if (old + 1u == (gen + 1u) * nloc) {
            __builtin_amdgcn_fence(__ATOMIC_RELEASE, "agent");
            asm volatile("s_waitcnt vmcnt(0)" ::: "memory");
            const unsigned og = xb_add(&bar[XB_TOP], 1u);
            const unsigned tg = og / nx;
            if (og + 1u == (tg + 1u) * nx) xb_add(&bar[XB_TOPGEN], 1u);
            else XB_SPIN(xb_ld(&bar[XB_TOPGEN]) == tg, bar);
            __builtin_amdgcn_fence(__ATOMIC_ACQUIRE, "agent");
            xb_add(&bar[XB_XGEN(b.x)], 1u);
            asm volatile("s_waitcnt vmcnt(0)" ::: "memory");
        } else {
            XB_SPIN(xb_ld(&bar[XB_XGEN(b.x)]) == gen, bar);
            __builtin_amdgcn_fence(__ATOMIC_ACQUIRE, "agent");
            asm volatile("s_waitcnt vmcnt(0)" ::: "memory");
        }
    }
    __syncthreads();
}

struct Frame {
    LAS unsigned char* lds;
    int tid, lane, wave, vcu, G;
};

__device__ __forceinline__ void p0_transpose_item(const float* W, int K, int N, bf16_t* WT, LAS float* scr, int item, int lane, const float* gk = nullptr) {
    const int nblk = N / 32, kb = item / nblk, nb = item % nblk, k0 = 64 * kb, n0 = 32 * nb;
    float tv_[32];
#pragma unroll
    for (int i = 0; i < 32; ++i) tv_[i] = W[(size_t)(k0 + 2 * i + (lane >> 5)) * N + n0 + (lane & 31)];
    if (gk) {
#pragma unroll
        for (int i = 0; i < 32; ++i) tv_[i] *= gk[k0 + 2 * i + (lane >> 5)]; }
#pragma unroll
    for (int i = 0; i < 32; ++i) scr[(2 * i + (lane >> 5)) * 33 + (lane & 31)] = tv_[i];
    LDS_WAIT(); asm volatile("" ::: "memory");
    const int c = lane & 7;
#pragma unroll
    for (int j = 0; j < 4; ++j) { const int n = (lane >> 3) + 8 * j; const LAS float* s = scr + (8 * c) * 33 + n;
        u32x4 o; o.x = pk2(s[0 * 33], s[1 * 33]); o.y = pk2(s[2 * 33], s[3 * 33]); o.z = pk2(s[4 * 33], s[5 * 33]); o.w = pk2(s[6 * 33], s[7 * 33]);
        *(u32x4*)(WT + (size_t)(n0 + n) * K + k0 + 8 * c) = o; }
    LDS_WAIT(); asm volatile("" ::: "memory");
}
__device__ __forceinline__ void rms_row_2048(const float* xrow, const float* g, bf16_t* orow, int lane) {
    const f32x4* xr = (const f32x4*)xrow + lane; const f32x4* gr = (const f32x4*)g + lane;
    f32x4 v[8]; float s = 0.f;
#pragma unroll
    for (int j = 0; j < 8; ++j) { v[j] = xr[64 * j]; s += (v[j].x * v[j].x + v[j].y * v[j].y) + (v[j].z * v[j].z + v[j].w * v[j].w); }
    const float rstd = __builtin_amdgcn_rsqf(wave_sum(s) * (1.f / DM) + EPS);
    u32x2* o8 = (u32x2*)orow + lane;
#pragma unroll
    for (int j = 0; j < 8; ++j) { const f32x4 gg = gr[64 * j]; u32x2 w; w.x = pk2(v[j].x * rstd * gg.x, v[j].y * rstd * gg.y); w.y = pk2(v[j].z * rstd * gg.z, v[j].w * rstd * gg.w); o8[64 * j] = w; }
}

__device__ __forceinline__ void rms_row2_2048(const float* xa, const float* xb, const float* g, bf16_t* oa, bf16_t* ob, int lane) {
    const f32x4* ra = (const f32x4*)xa + lane; const f32x4* rb = (const f32x4*)xb + lane; const f32x4* gr = (const f32x4*)g + lane;
    f32x4 va[8], vb[8]; float sa = 0.f, sb = 0.f;
#pragma unroll
    for (int j = 0; j < 8; ++j) { va[j] = ra[64 * j]; vb[j] = rb[64 * j]; }
#pragma unroll
    for (int j = 0; j < 8; ++j) { sa += (va[j].x * va[j].x + va[j].y * va[j].y) + (va[j].z * va[j].z + va[j].w * va[j].w); sb += (vb[j].x * vb[j].x + vb[j].y * vb[j].y) + (vb[j].z * vb[j].z + vb[j].w * vb[j].w); }
    const float rsa = __builtin_amdgcn_rsqf(wave_sum(sa) * (1.f / DM) + EPS), rsb = __builtin_amdgcn_rsqf(wave_sum(sb) * (1.f / DM) + EPS);
    u32x2* o8a = (u32x2*)oa + lane; u32x2* o8b = (u32x2*)ob + lane;
#pragma unroll
    for (int j = 0; j < 8; ++j) { const f32x4 gg = gr[64 * j]; u32x2 w;
        w.x = pk2(va[j].x * rsa * gg.x, va[j].y * rsa * gg.y); w.y = pk2(va[j].z * rsa * gg.z, va[j].w * rsa * gg.w); o8a[64 * j] = w;
        w.x = pk2(vb[j].x * rsb * gg.x, vb[j].y * rsb * gg.y); w.y = pk2(vb[j].z * rsb * gg.z, vb[j].w * rsb * gg.w); o8b[64 * j] = w; }
}
#define O ((bf16_t*)(wsb + WS_KVR))
#define Z ((const bf16_t*)(wsb + WS_Z))
#define rt ((const float2*)(wsb + WS_ROPE))
#define KF ((bf16_t*)(wsb + WS_KF))
__device__ __forceinline__ void kv_post(unsigned char* wsb, const float* gk, const pg8::Unit& u, int tid_in) {
    int tid = tid_in; asm volatile("" : "+v"(tid));
    const int j = tid & 7, h = u.pn;
    float g[24];
#pragma unroll
    for (int c = 0; c < 3; ++c)
#pragma unroll
        for (int e = 0; e < 8; ++e) g[c * 8 + e] = gk[c * 64 + j * 8 + e];
    u32x4 w[4][3]; f32x4 rr[4][4];
#pragma unroll
    for (int ps = 0; ps < 4; ++ps) { const int row = u.pm * 256 + (tid >> 3) + 64 * ps; const int pos = row & (SEQ - 1);
        const bf16_t* kp = O + (size_t)row * 2048 + h * 256 + j * 8;
        w[ps][0] = *(const u32x4*)kp; w[ps][1] = *(const u32x4*)(kp + 64); w[ps][2] = *(const u32x4*)(Z + (size_t)row * ZC + C_KR + j * 8);
        const f32x4* r4 = (const f32x4*)(rt + (size_t)pos * 32 + (j & 3) * 8);
#pragma unroll
        for (int e = 0; e < 4; ++e) rr[ps][e] = r4[e]; }
#pragma unroll
    for (int ps = 0; ps < 4; ++ps) { const int row = u.pm * 256 + (tid >> 3) + 64 * ps;
        float v[24], cs[8], sn[8];
#pragma unroll
        for (int e = 0; e < 4; ++e) { const f32x4 t = rr[ps][e]; cs[2 * e] = t.x; sn[2 * e] = t.y; cs[2 * e + 1] = t.z; sn[2 * e + 1] = t.w; }
        unpack8(w[ps][0], v); unpack8(w[ps][1], v + 8); unpack8(w[ps][2], v + 16);
        float s2 = 0.f;
#pragma unroll
        for (int e = 0; e < 24; ++e) s2 += v[e] * v[e];
        s2 += __shfl_xor(s2, 1); s2 += __shfl_xor(s2, 2); s2 += __shfl_xor(s2, 4);
        const float rstd = __builtin_amdgcn_rsqf(s2 * (1.f / 192) + EPS);
#pragma unroll
        for (int e = 0; e < 24; ++e) v[e] = v[e] * rstd * g[e];
#pragma unroll
        for (int e = 0; e < 8; ++e) { const float own = v[16 + e], oth = __shfl_xor(own, 4);
            v[16 + e] = (j < 4) ? (own * cs[e] - oth * sn[e]) : (own * cs[e] + oth * sn[e]); }
        bf16_t* op = KF + (size_t)row * 1536 + h * 192 + j * 8;
        *(u32x4*)op = pack8f(v); *(u32x4*)(op + 64) = pack8f(v + 8); *(u32x4*)(op + 128) = pack8f(v + 16); }
}
#undef O
#undef Z
#undef rt
#undef KF
enum { I_X = 0, I_MEM, I_GMIX, I_WIN, I_GQLAT, I_WQUP, I_GKVLAT, I_WKVUP, I_GQMLA, I_GKMLA, I_WPOOL, I_PSCALE, I_GMEM, I_WMEMKV, I_GQX, I_GKX, I_WO, I_GFFN,
       I_WGATE, I_WUP, I_CONVW, I_CONVB, I_WDOWN };

__device__ __forceinline__ void phase0(const Params& p, Frame& F) {
    unsigned char* ws = p.ws;
    LAS float* scr = (LAS float*)(F.lds + F.wave * 16384);
    const int gw = F.vcu * 8 + F.wave, NGW = F.G * 8, lane = F.lane;
    constexpr int N_IN = (DM / 64) * (IN_COLS / 32), N_Q = (512 / 64) * (1536 / 32), N_KV = (256 / 64) * (2048 / 32), N_MEM = (DM / 64) * (1024 / 32),
                  N_O = (DM / 64) * (DM / 32), N_G = (DM / 64) * (DFF / 32), N_D = (DFF / 64) * (DM / 32);
    constexpr int NITEMS = N_IN + N_Q + N_KV + N_MEM + N_O + 2 * N_G + N_D;
    for (int it = gw; it < NITEMS; it += NGW) {
        int r = it;
        if (r < N_IN) { p0_transpose_item(p.in[I_WIN], DM, IN_COLS, (bf16_t*)(ws + WS_WIN), scr, r, lane); continue; } r -= N_IN;
        if (r < N_Q) { p0_transpose_item(p.in[I_WQUP], 512, 1536, (bf16_t*)(ws + WS_WQ), scr, r, lane, p.in[I_GQLAT]); continue; } r -= N_Q;
        if (r < N_KV) { p0_transpose_item(p.in[I_WKVUP], 256, 2048, (bf16_t*)(ws + WS_WKV), scr, r, lane, p.in[I_GKVLAT]); continue; } r -= N_KV;
        if (r < N_MEM) { p0_transpose_item(p.in[I_WMEMKV], DM, 1024, (bf16_t*)(ws + WS_WMEM), scr, r, lane); continue; } r -= N_MEM;
        if (r < N_O) { p0_transpose_item(p.in[I_WO], DM, DM, (bf16_t*)(ws + WS_WO), scr, r, lane); continue; } r -= N_O;
        if (r < N_G) { p0_transpose_item(p.in[I_WGATE], DM, DFF, (bf16_t*)(ws + WS_WG), scr, r, lane); continue; } r -= N_G;
        if (r < N_G) { p0_transpose_item(p.in[I_WUP], DM, DFF, (bf16_t*)(ws + WS_WU), scr, r, lane); continue; } r -= N_G;
        p0_transpose_item(p.in[I_WDOWN], DFF, DM, (bf16_t*)(ws + WS_WD), scr, r, lane);
    }
    { bf16_t* wt = (bf16_t*)(ws + WS_WIN) + (size_t)IN_COLS * DM; const int n16 = (ZC - IN_COLS) * DM * 2 / 16; const u32x4 z = {0u, 0u, 0u, 0u};
      for (int i = gw * 64 + lane; i < n16; i += NGW * 64) ((u32x4*)wt)[i] = z; }
    { bf16_t* wt = (bf16_t*)(ws + WS_WPOOL); const float* wp = p.in[I_WPOOL]; const float* sc = p.in[I_PSCALE];
      for (int i = gw * 64 + lane; i < 512 * 512; i += NGW * 64) { const int n = i >> 9, k = i & 511; float v = 0.f;
          if ((n >> 7) == (k >> 7)) v = wp[(size_t)(n >> 7) * 16384 + (k & 127) * 128 + (n & 127)] * sc[n];
          wt[i] = (bf16_t)f2bf(v); } }
    { float* ss = (float*)(ws + WS_SS); for (int i = gw * 64 + lane; i < T; i += NGW * 64) ss[i] = 0.f; }
    { float2* rt = (float2*)(ws + WS_ROPE);
      for (int i = gw * 64 + lane; i < SEQ * 32; i += NGW * 64) { const int pos = i >> 5, k = i & 31; const float ang = (float)pos * p.inv_freq[k];
          float s, c; sincosf(ang, &s, &c); rt[i] = make_float2(c, s); } }
    for (int m = gw; m < T; m += 2 * NGW) { const int m2 = (m + NGW < T) ? m + NGW : m;
        rms_row2_2048(p.in[I_X] + (size_t)m * DM, p.in[I_X] + (size_t)m2 * DM, p.in[I_GMIX], (bf16_t*)(ws + WS_XN) + (size_t)m * DM, (bf16_t*)(ws + WS_XN) + (size_t)m2 * DM, lane); }
    for (int m = gw; m < MROWS; m += NGW) rms_row_2048(p.in[I_MEM] + (size_t)m * DM, p.in[I_GMEM], (bf16_t*)(ws + WS_MEMN) + (size_t)m * DM, lane);
}

__device__ __forceinline__ void phase2(const Params& p, Frame& F) {
    unsigned char* ws = p.ws; const int lane = F.lane;
    const bool split = F.G >= 64; const int gw = (split ? (int)blockIdx.x - 16 : (int)blockIdx.x) * 8 + F.wave, NGW = (split ? F.G - 16 : F.G) * 8;
    const bf16_t* Z = (const bf16_t*)(ws + WS_Z);
    float gq[8], gkv[8], gx[8];
#pragma unroll
    for (int e = 0; e < 8; ++e) { gq[e] = p.in[I_GQLAT][lane * 8 + e]; gkv[e] = p.in[I_GKVLAT][(lane & 31) * 8 + e]; gx[e] = p.in[I_GQX][(lane & 15) * 8 + e]; }
    for (int m = gw; m < T; m += NGW) {
        const bf16_t* zr = Z + (size_t)m * ZC; const int tt = m & (SEQ - 1);
        const int w = 2 << (lane >> 4); const int cnt = (tt + 1) < w ? (tt + 1) : w;
        u32x4 wr_[16];
#pragma unroll
        for (int j = 0; j < 16; ++j) wr_[j] = *(const u32x4*)(zr - (size_t)(j < cnt ? j : 0) * ZC + lane * 8);
        const u32x4 wq = *(const u32x4*)(zr + C_Q + lane * 8), wkv = *(const u32x4*)(zr + C_KV + (lane & 31) * 8);
        { float s[8], self[8], f[8];
          unpack8(wr_[0], self);
#pragma unroll
          for (int e = 0; e < 8; ++e) s[e] = self[e];
#pragma unroll
          for (int j = 1; j < 16; ++j) { unpack8(wr_[j], f); const float on = j < cnt ? 1.f : 0.f;
#pragma unroll
              for (int e = 0; e < 8; ++e) s[e] = fmaf(on, f[e], s[e]); }
          const float ic = __builtin_amdgcn_rcpf((float)cnt);
#pragma unroll
          for (int e = 0; e < 8; ++e) f[e] = s[e] * ic - self[e];
          *(u32x4*)((bf16_t*)(ws + WS_DP) + (size_t)m * 512 + lane * 8) = pack8f(f); }
        { float v[8]; unpack8(wq, v); float ss = 0.f;
#pragma unroll
          for (int e = 0; e < 8; ++e) ss += v[e] * v[e];
          const float sq = wave_sum(ss); if (lane == 0) ((float*)(ws + WS_SSQQ))[m] = sq; }
        { float v[8]; unpack8(wkv, v); float ss = 0.f;
#pragma unroll
          for (int e = 0; e < 8; ++e) ss += v[e] * v[e];
          if (lane >= 32) ss = 0.f;
          const float sq = wave_sum(ss); if (lane == 0) ((float*)(ws + WS_SSQKV))[m] = sq; }
    }
}

__device__ __forceinline__ void phase4(const Params& p, Frame& F) {
    unsigned char* ws = p.ws; const int gw = F.vcu * 8 + F.wave, NGW = F.G * 8, lane = F.lane;
    {
    float gkx[8];
#pragma unroll
    for (int e = 0; e < 8; ++e) gkx[e] = p.in[I_GKX][(lane & 15) * 8 + e];
    for (int m = gw; m < MROWS; m += NGW) {
        float v[8]; unpack8(*(const u32x4*)((const bf16_t*)(ws + WS_MKV) + (size_t)m * 1024 + lane * 8), v); float ss = 0.f;
#pragma unroll
        for (int e = 0; e < 8; ++e) ss += v[e] * v[e];
        ss += __shfl_xor(ss, 1); ss += __shfl_xor(ss, 2); ss += __shfl_xor(ss, 4); ss += __shfl_xor(ss, 8);
        const float rstd = __builtin_amdgcn_rsqf(ss * (1.f / 128) + EPS);
#pragma unroll
        for (int e = 0; e < 8; ++e) v[e] = v[e] * rstd * gkx[e];
        *(u32x4*)((bf16_t*)(ws + WS_MKF) + (size_t)m * 512 + lane * 8) = pack8f(v);
    }
    }
    const int head = lane >> 3, j = lane & 7;
    float gq[24], gk[24];
#pragma unroll
    for (int c = 0; c < 3; ++c)
#pragma unroll
        for (int e = 0; e < 8; ++e) { gq[c * 8 + e] = p.in[I_GQMLA][c * 64 + j * 8 + e]; gk[c * 8 + e] = p.in[I_GKMLA][c * 64 + j * 8 + e]; }
    const float2* rt = (const float2*)(ws + WS_ROPE);
    const bf16_t* Z = (const bf16_t*)(ws + WS_Z);
    for (int m0 = gw; m0 < T; m0 += 2 * NGW) {
        f32x4 rr_[2][4]; u32x4 wk_[2][3]; int mm_[2];
#pragma unroll
        for (int u = 0; u < 2; ++u) { const int m = (m0 + u * NGW < T) ? m0 + u * NGW : m0; mm_[u] = m; const int pos = m & (SEQ - 1);
            const f32x4* r4 = (const f32x4*)(rt + (size_t)pos * 32 + (j & 3) * 8);
#pragma unroll
            for (int e = 0; e < 4; ++e) rr_[u][e] = r4[e];
            const bf16_t* kp = (const bf16_t*)(ws + WS_KVR) + (size_t)m * 2048 + head * 256 + j * 8;
            wk_[u][0] = *(const u32x4*)kp; wk_[u][1] = *(const u32x4*)(kp + 64); wk_[u][2] = *(const u32x4*)(Z + (size_t)m * ZC + C_KR + j * 8); }
#pragma unroll
        for (int u = 0; u < 2; ++u) { const int m = mm_[u];
            if (u == 1 && m0 + NGW >= T) break;
            float cs[8], sn[8];
#pragma unroll
            for (int e = 0; e < 4; ++e) { const f32x4 q = rr_[u][e]; cs[2 * e] = q.x; sn[2 * e] = q.y; cs[2 * e + 1] = q.z; sn[2 * e + 1] = q.w; }
#pragma unroll
            for (int which = 1; which < 2; ++which) {
                float v[24];
                { unpack8(wk_[u][0], v); unpack8(wk_[u][1], v + 8); unpack8(wk_[u][2], v + 16); }
                float ss = 0.f;
#pragma unroll
                for (int e = 0; e < 24; ++e) ss += v[e] * v[e];
                ss += __shfl_xor(ss, 1); ss += __shfl_xor(ss, 2); ss += __shfl_xor(ss, 4);
                const float rstd = __builtin_amdgcn_rsqf(ss * (1.f / 192) + EPS);
#pragma unroll
                for (int e = 0; e < 24; ++e) v[e] = v[e] * rstd * (which == 0 ? gq[e] : gk[e]);
#pragma unroll
                for (int e = 0; e < 8; ++e) { const float own = v[16 + e], oth = __shfl_xor(own, 4);
                    v[16 + e] = (j < 4) ? (own * cs[e] - oth * sn[e]) : (own * cs[e] + oth * sn[e]); }
                bf16_t* op = (which == 0) ? ((bf16_t*)(ws + WS_QF) + (size_t)m * 1536 + head * 192 + j * 8) : ((bf16_t*)(ws + WS_KF) + (size_t)m * 1536 + head * 192 + j * 8);
                *(u32x4*)op = pack8f(v); *(u32x4*)(op + 64) = pack8f(v + 8); *(u32x4*)(op + 128) = pack8f(v + 16);
            }
        }
    }
}

#ifndef MLA_DQK
#define MLA_DQK 192
#endif
typedef att::Cfg<MLA_DQK, 1536, 1536, 2048, 2048> CfgMLA;
typedef att::Cfg<128, 2048, 512, 1024, 2048> CfgX;
__device__ __forceinline__ att::BlockRef mla_ref(unsigned char* ws, int L, int pass) {
    const int bh = L >> 4, x = L & 15, b = bh >> 3, h = bh & 7; const int qb = pass ? 31 - x : x;
    att::BlockRef r; const size_t row0 = (size_t)b * SEQ;
    r.Q = (const bf16_t*)(ws + WS_QR) + (row0 + (size_t)qb * 256) * 1536 + h * 192;
    r.K = (const bf16_t*)(ws + WS_KF) + row0 * 1536 + h * 192;
    r.V = (const bf16_t*)(ws + WS_KVR) + row0 * 2048 + h * 256 + 128;
    r.O = (bf16_t*)(ws + WS_Y) + (row0 + (size_t)qb * 256) * 2048 + 512 + h * 128;
    r.P0 = qb * 256; return r;
}
__device__ __forceinline__ att::BlockRef x_ref(unsigned char* ws, int L) {
    const int qb = L & 31, hx = (L >> 5) & 3, b = L >> 7;
    att::BlockRef r; const size_t row0 = (size_t)b * SEQ + (size_t)qb * 256;
    r.Q = (const bf16_t*)(ws + WS_Z) + row0 * ZC + C_MQ + hx * 128;
    r.K = (const bf16_t*)(ws + WS_MKF) + (size_t)b * MEML * 512 + hx * 128;
    r.V = (const bf16_t*)(ws + WS_MKV) + (size_t)b * MEML * 1024 + 512 + hx * 128;
    r.O = (bf16_t*)(ws + WS_Y) + row0 * 2048 + 1536 + hx * 128;
    r.P0 = MEML; return r;
}
__device__ __forceinline__ void phase5(const Params& p, Frame& F, char* lds) {
    unsigned char* ws = p.ws;
    {
        att::Seam<CfgMLA> S;
        const int total = 512; int L = F.vcu, pass = 0;
        if (L < total) {
            att::BlockRef cur = mla_ref(ws, L, 0);
            att::prime<CfgMLA>(cur, lds, S);
            for (;;) {
                int Ln = L, passn = pass + 1; bool last = false;
                if (pass == 1) { passn = 0; if (L + F.G < total) Ln = L + F.G; else last = true; }
                const att::BlockRef nxt = last ? cur : mla_ref(ws, Ln, passn);
                att::block<CfgMLA>(cur, nxt, SEQ, lds, S, p.in[I_GQMLA], (const float2*)(ws + WS_ROPE));
                if (last) break;
                cur = nxt; L = Ln; pass = passn;
            }
        }
    }
    {
        att::Seam<CfgX> S;
        const int total = 512; int L = F.vcu;
        if (L < total) {
            att::BlockRef cur = x_ref(ws, L);
            att::prime<CfgX>(cur, lds, S);
            for (;;) {
                const bool last = !(L + F.G < total); const int Ln = last ? L : L + F.G;
                const att::BlockRef nxt = last ? cur : x_ref(ws, Ln);
                att::block<CfgX>(cur, nxt, MEML, lds, S, p.in[I_GQX], nullptr);
                if (last) break;
                cur = nxt; L = Ln;
            }
        }
    }
}

template <int PH> __device__ __forceinline__ void run_phase(const Params& p, Frame& F, unsigned char* lds) {
    unsigned char* ws = p.ws; typedef pg8::StaticOrder SO;
    if constexpr (PH == 0) { phase0(p, F); }
    if constexpr (PH == 1) {
        { pg8::Gemm g{(const bf16_t*)(ws + WS_XN), (const bf16_t*)(ws + WS_WIN), T, ZC, DM, DM}; SO S; S.init(T, ZC, F.G, (int)blockIdx.x);
          pg8::EpiBf16 E{(bf16_t*)(ws + WS_Z), ZC}; pg8::gemm_phase(F.lds, g, S, E); }
    }
    if constexpr (PH == 2) {
        if (F.G >= 64 && blockIdx.x < 16) {
        { pg8::Gemm g{(const bf16_t*)(ws + WS_MEMN), (const bf16_t*)(ws + WS_WMEM), MROWS, 1024, DM, DM}; SO S; S.init(MROWS, 1024, F.G, (int)blockIdx.x);
          pg8::EpiBf16 E{(bf16_t*)(ws + WS_MKV), 1024}; pg8::gemm_phase(F.lds, g, S, E); }
        } else phase2(p, F);
    }
    if constexpr (PH == 3) {
        {
            const int gw = F.vcu * 8 + F.wave, NGW = F.G * 8, lane = F.lane; float gkx[8];
#pragma unroll
            for (int e = 0; e < 8; ++e) gkx[e] = p.in[I_GKX][(lane & 15) * 8 + e];
            for (int m = gw; m < MROWS; m += NGW) {
                float v[8]; unpack8(*(const u32x4*)((const bf16_t*)(ws + WS_MKV) + (size_t)m * 1024 + lane * 8), v); float s2 = 0.f;
#pragma unroll
                for (int e = 0; e < 8; ++e) s2 += v[e] * v[e];
                s2 += __shfl_xor(s2, 1); s2 += __shfl_xor(s2, 2); s2 += __shfl_xor(s2, 4); s2 += __shfl_xor(s2, 8);
                const float rstd = __builtin_amdgcn_rsqf(s2 * (1.f / 128) + EPS);
#pragma unroll
                for (int e = 0; e < 8; ++e) v[e] = v[e] * rstd * gkx[e];
                *(u32x4*)((bf16_t*)(ws + WS_MKF) + (size_t)m * 512 + lane * 8) = pack8f(v);
            }
        }
        { pg8::Gemm g{(const bf16_t*)(ws + WS_Z) + C_Q, (const bf16_t*)(ws + WS_WQ), T, 1536, 512, ZC}; SO S; S.init(T, 1536, F.G, (int)blockIdx.x);
          pg8::EpiBf16Rs E{(bf16_t*)(ws + WS_QR), 1536, (const float*)(ws + WS_SSQQ), 1.f / 512}; pg8::gemm_phase(F.lds, g, S, E); }
        { pg8::Gemm g{(const bf16_t*)(ws + WS_Z) + C_KV, (const bf16_t*)(ws + WS_WKV), T, 2048, 256, ZC}; SO S; S.init(T, 2048, F.G, (int)blockIdx.x);
          pg8::EpiBf16Rs E{(bf16_t*)(ws + WS_KVR), 2048, (const float*)(ws + WS_SSQKV), 1.f / 256}; pg8::gemm_phase(F.lds, g, S, E);
          pg8::Unit u; for (int i = 0; S.next(i, u); ++i) kv_post(ws, p.in[I_GKMLA], u, F.tid); }
        { pg8::Gemm g{(const bf16_t*)(ws + WS_DP), (const bf16_t*)(ws + WS_WPOOL), T, 512, 512, 512}; SO S; S.init(T, 512, F.G, (int)blockIdx.x);
          pg8::EpiBf16 E{(bf16_t*)(ws + WS_Y), 2048}; pg8::gemm_phase(F.lds, g, S, E); }
    }
    if constexpr (PH == 4) { }
    if constexpr (PH == 5) { phase5(p, F, (char*)lds); }
    if constexpr (PH == 6) {
        pg8::Gemm g{(const bf16_t*)(ws + WS_Y), (const bf16_t*)(ws + WS_WO), T, DM, DM, DM}; SO S; S.init(T, DM, F.G, (int)blockIdx.x);
        pg8::EpiResNorm E{p.in[I_X], p.out, p.in[I_GFFN], (bf16_t*)(ws + WS_H2), (float*)(ws + WS_SS), DM}; pg8::gemm_phase(F.lds, g, S, E);
    }
    if constexpr (PH == 8) {
        pg8::Gemm g{(const bf16_t*)(ws + WS_H2), (const bf16_t*)(ws + WS_WG), T, DFF, DM, DM}; SO S; S.init(T, DFF, F.G, (int)blockIdx.x);
        pg8::EpiBf16Rs E{(bf16_t*)(ws + WS_G), DFF, (const float*)(ws + WS_SS), 1.f / DM}; pg8::gemm_phase(F.lds, g, S, E);
    }
    if constexpr (PH == 9) {
        pg8::Gemm g{(const bf16_t*)(ws + WS_H2), (const bf16_t*)(ws + WS_WU), T, DFF, DM, DM}; SO S; S.init(T, DFF, F.G, (int)blockIdx.x);
        pg8::EpiGlu E{(const bf16_t*)(ws + WS_G), p.in[I_CONVW], p.in[I_CONVB], (bf16_t*)(ws + WS_ACT), (const float*)(ws + WS_SS)}; pg8::gemm_phase(F.lds, g, S, E);
    }
    if constexpr (PH == 10) {
        pg8::Gemm g{(const bf16_t*)(ws + WS_ACT), (const bf16_t*)(ws + WS_WD), T, DM, DFF, DFF}; SO S; S.init(T, DM, F.G, (int)blockIdx.x);
        pg8::EpiResF32 E{p.out, p.out, DM}; pg8::gemm_phase(F.lds, g, S, E);
    }
}

__global__ void __launch_bounds__(512, 2) mk_fwd(Params p) {
    extern __shared__ __attribute__((aligned(16))) unsigned char lds[];
    Frame F;
    F.lds = (LAS unsigned char*)lds;
    F.tid = threadIdx.x; F.lane = F.tid & 63; F.wave = __builtin_amdgcn_readfirstlane(F.tid >> 6);
    F.G = gridDim.x; { const int bx = blockIdx.x; F.vcu = (F.G % 8 == 0) ? (bx % 8) * (F.G / 8) + bx / 8 : bx; }
    unsigned char* ws = p.ws;
    const int lo = p.ph_lo, hi = p.ph_hi;
    volatile LAS unsigned* MISC = (volatile LAS unsigned*)(F.lds + 131072 + 320);
    if (F.tid < 32) MISC[F.tid] = 0u;
    __syncthreads();
    XcdBarrier bar = xcd_barrier_post((unsigned*)ws, MISC + 8);
#ifndef PH_MASK
#define PH_MASK 0x7ff
#endif
#define IN(k) (((PH_MASK >> (k)) & 1) && lo <= (k) && (k) < hi)
#define SEAM(k) do { if (IN(k) && IN((k) + 1)) xcd_barrier(bar); } while (0)
    if (lo < 0) { __threadfence(); cg::this_grid().sync(); }
#ifndef DUP_MASK
#define DUP_MASK 0
#endif
#define PHASE(k) do { if (IN(k)) { run_phase<k>(p, F, lds); if ((DUP_MASK >> (k)) & 1) { xcd_barrier(bar); run_phase<k>(p, F, lds); } } SEAM(k); } while (0)
    PHASE(0); PHASE(1); PHASE(2); PHASE(3); PHASE(5); PHASE(6); PHASE(8); PHASE(9);
    if (IN(10)) run_phase<10>(p, F, lds);
#undef PHASE
#undef IN
#undef SEAM
}

extern "C" void kernel_launch(void* const* d_in, const int* in_sizes, int n_in, void* d_out, int out_size, void* d_ws, size_t ws_size, hipStream_t stream) {
    static int grid = 0;
    if (grid == 0) {
        if (n_in != 23 || in_sizes[0] != T * DM || out_size != T * DM || ws_size < WS_END) {
            fprintf(stderr, "kernel_launch: unexpected shapes (n_in %d, in0 %d, out %d, ws %zu)\n", n_in, n_in > 0 ? in_sizes[0] : -1, out_size, ws_size); grid = -1; return; }
        int dev = 0, cus = 0, per_cu = 0;
        (void)hipGetDevice(&dev); (void)hipDeviceGetAttribute(&cus, hipDeviceAttributeMultiprocessorCount, dev);
        if (hipFuncSetAttribute((const void*)mk_fwd, hipFuncAttributeMaxDynamicSharedMemorySize, LDS_BYTES) != hipSuccess) { fprintf(stderr, "kernel_launch: hipFuncSetAttribute failed\n"); grid = -1; return; }
        if (hipOccupancyMaxActiveBlocksPerMultiprocessor(&per_cu, (const void*)mk_fwd, 512, LDS_BYTES) != hipSuccess || per_cu < 1) { fprintf(stderr, "kernel_launch: occupancy query says %d\n", per_cu); per_cu = 1; }
        (void)hipGetLastError();
        grid = cus * per_cu;
        if (grid <= 0) grid = 256;
    }
    if (grid < 0) return;
    Params p{};
    for (int i = 0; i < 23; ++i) p.in[i] = (const float*)d_in[i];
    p.out = (float*)d_out; p.ws = (unsigned char*)d_ws;
    for (int i = 0; i < 32; ++i) p.inv_freq[i] = 1.0f / powf(10000.0f, (float)i / 32.0f);
#if MK_SPLIT
    for (int ph = 0; ph < NPHASE; ++ph) { p.ph_lo = ph; p.ph_hi = ph + 1; hipLaunchKernelGGL(mk_fwd, dim3(grid), dim3(512), LDS_BYTES, stream, p); }
#else
    p.ph_lo = 0; p.ph_hi = NPHASE;
    (void)hipMemsetAsync(d_ws, 0, 16384, stream);
    void* args[] = {&p};
    hipError_t e = hipLaunchCooperativeKernel((const void*)mk_fwd, dim3(grid), dim3(512), args, LDS_BYTES, stream);
    if (e != hipSuccess) fprintf(stderr, "cooperative launch failed: %s (grid %d)\n", hipGetErrorString(e), grid);
#endif
}
```

```cpp
#include <hip/hip_runtime.h>
#include <hip/hip_cooperative_groups.h>
#include <cstdio>
#include <cstdint>
#include <cmath>
namespace cg = cooperative_groups;

#ifndef MK_SPLIT
#define MK_SPLIT 0
#endif

constexpr int NB = 4, SEQ = 8192, T = NB * SEQ, DM = 2048, MEML = 256, MROWS = NB * MEML;
constexpr int ZC = 2048;
constexpr int C_POOL = 0, C_Q = 512, C_KV = 1024, C_KR = 1280, C_MQ = 1344, IN_COLS = 1856;
constexpr int DFF = 5632;
constexpr float EPS = 1e-6f;
constexpr int NPHASE = 11;

#define LAS __attribute__((address_space(3)))
typedef unsigned short bf16_t;
typedef short bf16x8 __attribute__((ext_vector_type(8)));
typedef short s16x4 __attribute__((ext_vector_type(4)));
typedef float f32x4 __attribute__((ext_vector_type(4)));
typedef float f32x16 __attribute__((ext_vector_type(16)));
typedef unsigned u32x4 __attribute__((ext_vector_type(4)));
typedef unsigned u32x2 __attribute__((ext_vector_type(2)));

constexpr size_t MiB = 1u << 20;
constexpr size_t WS_SS = 1 * MiB;
constexpr size_t WS_SSQQ = 1 * MiB + 256 * 1024, WS_SSQKV = 1 * MiB + 512 * 1024;
constexpr size_t WS_WIN = 2 * MiB, WS_WQ = 10 * MiB, WS_WKV = 12 * MiB, WS_WPOOL = 13 * MiB, WS_WMEM = 14 * MiB, WS_WO = 18 * MiB;
constexpr size_t WS_WG = 26 * MiB, WS_WU = 48 * MiB, WS_WD = 70 * MiB, WS_MEMN = 92 * MiB, WS_MKV = 96 * MiB, WS_MKF = 98 * MiB, WS_ROPE = 99 * MiB;
constexpr size_t WS_XN = 128 * MiB, WS_Z = 256 * MiB, WS_DP = 384 * MiB, WS_QN = 416 * MiB, WS_KVN = 448 * MiB, WS_XQ = 464 * MiB;
constexpr size_t WS_QR = 496 * MiB, WS_KVR = 592 * MiB, WS_KF = 720 * MiB, WS_Y = 816 * MiB;
constexpr size_t WS_QF = 128 * MiB;
constexpr size_t WS_H2 = 128 * MiB, WS_G = 256 * MiB, WS_ACT = 608 * MiB, WS_END = 960 * MiB;

constexpr int LDS_BYTES = 147456;

struct Params {
    const float* in[23];
    float* out;
    unsigned char* ws;
    float inv_freq[32];
    int ph_lo, ph_hi;
};

__device__ __forceinline__ unsigned f2bf(float f) { unsigned u = __builtin_bit_cast(unsigned, f); return (u + 0x7fffu + ((u >> 16) & 1u)) >> 16; }
__device__ __forceinline__ unsigned cvt_pk_bf16(float lo, float hi) { unsigned r; asm volatile("v_cvt_pk_bf16_f32 %0, %1, %2" : "=v"(r) : "v"(lo), "v"(hi)); return r; }
__device__ __forceinline__ unsigned pk2(float lo, float hi) { return cvt_pk_bf16(lo, hi); }
__device__ __forceinline__ float bflo(unsigned w) { return __uint_as_float(w << 16); }
__device__ __forceinline__ float bfhi(unsigned w) { return __uint_as_float(w & 0xffff0000u); }
__device__ __forceinline__ void unpack8(u32x4 w, float* f) {
    f[0] = bflo(w.x); f[1] = bfhi(w.x); f[2] = bflo(w.y); f[3] = bfhi(w.y); f[4] = bflo(w.z); f[5] = bfhi(w.z); f[6] = bflo(w.w); f[7] = bfhi(w.w);
}
__device__ __forceinline__ u32x4 pack8f(const float* f) { u32x4 w; w.x = pk2(f[0], f[1]); w.y = pk2(f[2], f[3]); w.z = pk2(f[4], f[5]); w.w = pk2(f[6], f[7]); return w; }
__device__ __forceinline__ float wave_sum(float v) {
#pragma unroll
    for (int o = 1; o < 64; o <<= 1) v += __shfl_xor(v, o);
    return v;
}
#define LDS_WAIT() asm volatile("s_waitcnt lgkmcnt(0)" ::: "memory")

namespace pg8 {
constexpr int BM = 256, BK = 64, HALF = 128, HTB = HALF * BK * 2, STAGE_BYTES = 8 * HTB, NXCD = 8, WGM = 8;
__device__ __forceinline__ int lds_byte(int r, int c) { const int st = (r >> 4) * 2 + (c >> 5), rr = r & 15, cc = c & 31, ob = rr * 64 + cc * 2; return st * 1024 + (ob ^ (((ob >> 9) & 1) << 5)); }
__device__ __forceinline__ void stage_rc(int b, int& R, int& C) { const int st = b / 1024, sb = b % 1024, swz = sb ^ (((sb >> 9) & 1) << 5); R = (st >> 1) * 16 + swz / 64; C = (st & 1) * 32 + (swz % 64) / 2; }
__device__ __forceinline__ int perm32(int rho) { const int n = rho >> 4, i = rho & 15; return 8 * (i >> 2) + 4 * n + (i & 3); }

struct Unit { int pm, pn; };
struct Gemm { const bf16_t* A; const bf16_t* Bt; int M, N, K, lda; };

struct StaticOrder {
    int nM, nN, nwg, G, c;
    __device__ void init(int M, int N, int G_, int c_) { nM = M / BM; nN = N / BM; nwg = nM * nN; G = G_; c = c_; }
    __device__ bool next(int i, Unit& u) const {
        const long L = (long)i * G + c; if (L >= nwg) return false;
        int wgid = (int)L; { const int q = nwg / NXCD, r = nwg % NXCD, xcd = wgid % NXCD, off = wgid / NXCD; wgid = (xcd < r ? xcd * (q + 1) : r * (q + 1) + (xcd - r) * q) + off; }
        const int nig = WGM * nN, gid = wgid / nig, fm = gid * WGM, gsz = (nM - fm) < WGM ? (nM - fm) : WGM;
        u.pm = fm + ((wgid % nig) % gsz); u.pn = (wgid % nig) / gsz; return true;
    }
};

struct EpiBf16 {
    static constexpr bool PERM = true, POST = false;
    bf16_t* O; int ldc;
    __device__ __forceinline__ void operator()(const f32x4 (&acc)[2][2][4][2], const Unit& u, int wr, int wc, int fr, int fq) const {
        const int row0 = u.pm * BM + wr * 64 + fr, col0 = u.pn * BM + wc * 32 + 8 * fq;
#pragma unroll
        for (int ai = 0; ai < 2; ++ai)
#pragma unroll
            for (int m = 0; m < 4; ++m) { bf16_t* rowp = O + (size_t)(row0 + ai * HALF + m * 16) * ldc + col0;
#pragma unroll
                for (int bj = 0; bj < 2; ++bj) { const f32x4 v0 = acc[ai][bj][m][0], v1 = acc[ai][bj][m][1];
                    u32x4 w; w.x = cvt_pk_bf16(v0[0], v0[1]); w.y = cvt_pk_bf16(v0[2], v0[3]); w.z = cvt_pk_bf16(v1[0], v1[1]); w.w = cvt_pk_bf16(v1[2], v1[3]);
                    *(u32x4*)(rowp + bj * HALF) = w; } }
    }
};
struct EpiZ {
    static constexpr bool PERM = true, POST = false;
    bf16_t* O; int ldc; float* ssq; float* sskv;
    __device__ __forceinline__ void operator()(const f32x4 (&acc)[2][2][4][2], const Unit& u, int wr, int wc, int fr, int fq) const {
        const int row0 = u.pm * BM + wr * 64 + fr, col0 = u.pn * BM + wc * 32 + 8 * fq;
        float* sb = (u.pn == 2 || u.pn == 3) ? ssq : (u.pn == 4 ? sskv : nullptr);
#pragma unroll
        for (int ai = 0; ai < 2; ++ai)
#pragma unroll
            for (int m = 0; m < 4; ++m) { const int row = row0 + ai * HALF + m * 16; bf16_t* rowp = O + (size_t)row * ldc + col0; float s2 = 0.f;
#pragma unroll
                for (int bj = 0; bj < 2; ++bj) { const f32x4 v0 = acc[ai][bj][m][0], v1 = acc[ai][bj][m][1];
                    s2 += (v0[0] * v0[0] + v0[1] * v0[1]) + (v0[2] * v0[2] + v0[3] * v0[3]) + (v1[0] * v1[0] + v1[1] * v1[1]) + (v1[2] * v1[2] + v1[3] * v1[3]);
                    u32x4 w; w.x = cvt_pk_bf16(v0[0], v0[1]); w.y = cvt_pk_bf16(v0[2], v0[3]); w.z = cvt_pk_bf16(v1[0], v1[1]); w.w = cvt_pk_bf16(v1[2], v1[3]);
                    *(u32x4*)(rowp + bj * HALF) = w; }
                if (sb) { s2 += __shfl_xor(s2, 16); s2 += __shfl_xor(s2, 32); if (fq == 0) atomicAdd(sb + row, s2); } }
    }
};
struct EpiResF32 {
    static constexpr bool PERM = false, POST = false;
    const float* base; float* out; int ldc;
    __device__ __forceinline__ void operator()(const f32x4 (&acc)[2][2][4][2], const Unit& u, int wr, int wc, int fr, int fq) const {
        const int row0 = u.pm * BM + wr * 64 + fr, col0 = u.pn * BM + wc * 32 + 4 * fq;
#pragma unroll
        for (int ai = 0; ai < 2; ++ai)
#pragma unroll
            for (int m = 0; m < 4; ++m) { const size_t off = (size_t)(row0 + ai * HALF + m * 16) * ldc + col0;
                f32x4 bs[2][2];
#pragma unroll
                for (int bj = 0; bj < 2; ++bj)
#pragma unroll
                    for (int n = 0; n < 2; ++n) bs[bj][n] = *(const f32x4*)(base + off + bj * HALF + n * 16);
#pragma unroll
                for (int bj = 0; bj < 2; ++bj)
#pragma unroll
                    for (int n = 0; n < 2; ++n) *(f32x4*)(out + off + bj * HALF + n * 16) = bs[bj][n] + acc[ai][bj][m][n];
                if (m & 1) asm volatile("" ::: "memory"); }
    }
};
struct EpiResNorm {
    static constexpr bool PERM = true, POST = false;
    const float* base; float* out; const float* g; bf16_t* H; float* ss; int ldc;
    __device__ __forceinline__ void operator()(const f32x4 (&acc)[2][2][4][2], const Unit& u, int wr, int wc, int fr, int fq) const {
        const int row0 = u.pm * BM + wr * 64 + fr, col0 = u.pn * BM + wc * 32 + 8 * fq;
        f32x4 gv[2][2];
#pragma unroll
        for (int bj = 0; bj < 2; ++bj)
#pragma unroll
            for (int n = 0; n < 2; ++n) gv[bj][n] = *(const f32x4*)(g + col0 + bj * HALF + 4 * n);
#pragma unroll
        for (int ai = 0; ai < 2; ++ai)
#pragma unroll
            for (int m = 0; m < 4; ++m) { const int row = row0 + ai * HALF + m * 16; const size_t off = (size_t)row * ldc + col0;
                f32x4 x[2][2]; float s = 0.f;
#pragma unroll
                for (int bj = 0; bj < 2; ++bj)
#pragma unroll
                    for (int n = 0; n < 2; ++n) x[bj][n] = *(const f32x4*)(base + off + bj * HALF + 4 * n);
#pragma unroll
                for (int bj = 0; bj < 2; ++bj) {
#pragma unroll
                    for (int n = 0; n < 2; ++n) { x[bj][n] = x[bj][n] + acc[ai][bj][m][n]; *(f32x4*)(out + off + bj * HALF + 4 * n) = x[bj][n];
                        s += (x[bj][n][0] * x[bj][n][0] + x[bj][n][1] * x[bj][n][1]) + (x[bj][n][2] * x[bj][n][2] + x[bj][n][3] * x[bj][n][3]); }
                    const f32x4 h0 = x[bj][0] * gv[bj][0], h1 = x[bj][1] * gv[bj][1];
                    u32x4 w; w.x = cvt_pk_bf16(h0[0], h0[1]); w.y = cvt_pk_bf16(h0[2], h0[3]); w.z = cvt_pk_bf16(h1[0], h1[1]); w.w = cvt_pk_bf16(h1[2], h1[3]);
                    *(u32x4*)(H + off + bj * HALF) = w; }
                s += __shfl_xor(s, 16); s += __shfl_xor(s, 32);
                if (fq == 0) atomicAdd(ss + row, s);
                if (m & 1) asm volatile("" ::: "memory"); }
    }
};
struct EpiBf16Rs {
    static constexpr bool PERM = true, POST = false;
    bf16_t* O; int ldc; const float* ss; float inv_n;
    __device__ __forceinline__ void operator()(const f32x4 (&acc)[2][2][4][2], const Unit& u, int wr, int wc, int fr, int fq) const {
        const int row0 = u.pm * BM + wr * 64 + fr, col0 = u.pn * BM + wc * 32 + 8 * fq;
#pragma unroll
        for (int ai = 0; ai < 2; ++ai)
#pragma unroll
            for (int m = 0; m < 4; ++m) { const int row = row0 + ai * HALF + m * 16; bf16_t* rowp = O + (size_t)row * ldc + col0;
                const float rs = __builtin_amdgcn_rsqf(ss[row] * inv_n + EPS);
#pragma unroll
                for (int bj = 0; bj < 2; ++bj) { const f32x4 v0 = acc[ai][bj][m][0] * rs, v1 = acc[ai][bj][m][1] * rs;
                    u32x4 w; w.x = cvt_pk_bf16(v0[0], v0[1]); w.y = cvt_pk_bf16(v0[2], v0[3]); w.z = cvt_pk_bf16(v1[0], v1[1]); w.w = cvt_pk_bf16(v1[2], v1[3]);
                    *(u32x4*)(rowp + bj * HALF) = w; } }
    }
};
struct EpiKv {
    static constexpr bool PERM = true, POST = true;
    unsigned char* wsb; const float* gk;
    static constexpr int ldc = 2048; static constexpr float inv_n = 1.f / 256;
#define O ((bf16_t*)(wsb + WS_KVR))
#define ss ((const float*)(wsb + WS_SSQKV))
#define Z ((const bf16_t*)(wsb + WS_Z))
#define rt ((const float2*)(wsb + WS_ROPE))
#define KF ((bf16_t*)(wsb + WS_KF))
    __device__ __forceinline__ void operator()(const f32x4 (&acc)[2][2][4][2], const Unit& u, int wr, int wc, int fr, int fq) const {
        const int row0 = u.pm * BM + wr * 64 + fr, col0 = u.pn * BM + wc * 32 + 8 * fq;
#pragma unroll
        for (int ai = 0; ai < 2; ++ai)
#pragma unroll
            for (int m = 0; m < 4; ++m) { const int row = row0 + ai * HALF + m * 16; bf16_t* rowp = O + (size_t)row * ldc + col0;
                const float rs = __builtin_amdgcn_rsqf(ss[row] * inv_n + EPS);
#pragma unroll
                for (int bj = 0; bj < 2; ++bj) { const f32x4 v0 = acc[ai][bj][m][0] * rs, v1 = acc[ai][bj][m][1] * rs;
                    u32x4 w; w.x = cvt_pk_bf16(v0[0], v0[1]); w.y = cvt_pk_bf16(v0[2], v0[3]); w.z = cvt_pk_bf16(v1[0], v1[1]); w.w = cvt_pk_bf16(v1[2], v1[3]);
                    *(u32x4*)(rowp + bj * HALF) = w; } }
    }
    __device__ __forceinline__ void post(const Unit& u, int tid_in) const {
        int tid = tid_in; asm volatile("" : "+v"(tid));
        const int j = tid & 7, h = u.pn;
#pragma unroll 1
        for (int ps = 0; ps < 4; ++ps) {
            const int row = u.pm * BM + (tid >> 3) + 64 * ps; const int pos = row & (SEQ - 1);
            const bf16_t* kp = O + (size_t)row * ldc + h * 256 + j * 8;
            const u32x4 w0 = *(const u32x4*)kp, w1 = *(const u32x4*)(kp + 64), w2 = *(const u32x4*)(Z + (size_t)row * ZC + C_KR + j * 8);
            const f32x4* r4 = (const f32x4*)(rt + (size_t)pos * 32 + (j & 3) * 8);
            const f32x4 r0 = r4[0], r1 = r4[1], r2 = r4[2], r3 = r4[3];
            float v[24];
            unpack8(w0, v); unpack8(w1, v + 8); unpack8(w2, v + 16);
            float s2 = 0.f;
#pragma unroll
            for (int e = 0; e < 24; ++e) s2 += v[e] * v[e];
            s2 += __shfl_xor(s2, 1); s2 += __shfl_xor(s2, 2); s2 += __shfl_xor(s2, 4);
            const float rstd = __builtin_amdgcn_rsqf(s2 * (1.f / 192) + EPS);
#pragma unroll
            for (int c = 0; c < 3; ++c) { const f32x4 ga = *(const f32x4*)(gk + c * 64 + j * 8), gb = *(const f32x4*)(gk + c * 64 + j * 8 + 4);
                v[c * 8 + 0] *= rstd * ga.x; v[c * 8 + 1] *= rstd * ga.y; v[c * 8 + 2] *= rstd * ga.z; v[c * 8 + 3] *= rstd * ga.w;
                v[c * 8 + 4] *= rstd * gb.x; v[c * 8 + 5] *= rstd * gb.y; v[c * 8 + 6] *= rstd * gb.z; v[c * 8 + 7] *= rstd * gb.w; }
            const float cs[8] = {r0.x, r0.z, r1.x, r1.z, r2.x, r2.z, r3.x, r3.z}, sn[8] = {r0.y, r0.w, r1.y, r1.w, r2.y, r2.w, r3.y, r3.w};
#pragma unroll
            for (int e = 0; e < 8; ++e) { const float own = v[16 + e], oth = __shfl_xor(own, 4);
                v[16 + e] = (j < 4) ? (own * cs[e] - oth * sn[e]) : (own * cs[e] + oth * sn[e]); }
            bf16_t* op = KF + (size_t)row * 1536 + h * 192 + j * 8;
            *(u32x4*)op = pack8f(v); *(u32x4*)(op + 64) = pack8f(v + 8); *(u32x4*)(op + 128) = pack8f(v + 16);
        }
    }
};
#undef O
#undef ss
#undef Z
#undef rt
#undef KF
struct EpiGlu {
    static constexpr bool PERM = true, POST = false;
    const bf16_t* G; const float* cw; const float* cb; bf16_t* O; const float* ss;
    __device__ __forceinline__ void operator()(const f32x4 (&acc)[2][2][4][2], const Unit& u, int wr, int wc, int fr, int fq) const {
        const int row0 = u.pm * BM + wr * 64 + fr;
#pragma unroll
        for (int bj = 0; bj < 2; ++bj) {
            const int col0 = u.pn * BM + bj * HALF + wc * 32 + 8 * fq;
            float w0[8], w1[8], w2[8], b[8];
#pragma unroll
            for (int e = 0; e < 8; e += 4) {
                *(f32x4*)(w0 + e) = *(const f32x4*)(cw + col0 + e); *(f32x4*)(w1 + e) = *(const f32x4*)(cw + DFF + col0 + e);
                *(f32x4*)(w2 + e) = *(const f32x4*)(cw + 2 * DFF + col0 + e); *(f32x4*)(b + e) = *(const f32x4*)(cb + col0 + e); }
#pragma unroll
            for (int ai = 0; ai < 2; ++ai) {
#pragma unroll
              for (int mp = 0; mp < 4; mp += 2) {
                u32x4 g0[4], g1[4], g2[4]; float rs[4];
#pragma unroll
                for (int m = mp; m < mp + 2; ++m) {
                    const int row = row0 + ai * HALF + m * 16; const int tpos = row & (SEQ - 1);
                    const bf16_t* gp = G + (size_t)row * DFF + col0;
                    g2[m] = *(const u32x4*)gp;
                    const bool edge = (ai == 0 && m == 0);
                    g1[m] = *(const u32x4*)(gp - ((!edge || tpos >= 1) ? DFF : 0));
                    g0[m] = *(const u32x4*)(gp - ((!edge || tpos >= 2) ? 2 * DFF : 0));
                    rs[m] = ss[row];
                }
#pragma unroll
                for (int m = mp; m < mp + 2; ++m) {
                    const int row = row0 + ai * HALF + m * 16; const int tpos = row & (SEQ - 1);
                    const u32x4 z4 = {0u, 0u, 0u, 0u};
                    float f0[8], f1[8], f2[8], o[8];
                    const bool edge = (ai == 0 && m == 0);
                    unpack8((!edge || tpos >= 2) ? g0[m] : z4, f0); unpack8((!edge || tpos >= 1) ? g1[m] : z4, f1); unpack8(g2[m], f2);
                    const float r = __builtin_amdgcn_rsqf(rs[m] * (1.f / DM) + EPS);
                    const f32x4 v0 = acc[ai][bj][m][0] * r, v1 = acc[ai][bj][m][1] * r;
                    const float uu[8] = {v0[0], v0[1], v0[2], v0[3], v1[0], v1[1], v1[2], v1[3]};
#pragma unroll
                    for (int e = 0; e < 8; ++e) { const float gc = b[e] + w0[e] * f0[e] + w1[e] * f1[e] + w2[e] * f2[e];
                        const float sg = __builtin_amdgcn_rcpf(1.0f + __builtin_amdgcn_exp2f(-gc * 1.4426950408889634f));
                        o[e] = gc * sg * uu[e]; }
                    u32x4 w; w.x = cvt_pk_bf16(o[0], o[1]); w.y = cvt_pk_bf16(o[2], o[3]); w.z = cvt_pk_bf16(o[4], o[5]); w.w = cvt_pk_bf16(o[6], o[7]);
                    *(u32x4*)(O + (size_t)row * DFF + col0) = w;
                }
                asm volatile("" ::: "memory");
              }
            }
        }
    }
};

#ifndef PG8_SP2
#define PG8_SP2 true
#endif
template <class Epi, class Sched, bool SP2 = PG8_SP2>
__device__ __forceinline__ void gemm_phase(LAS unsigned char* lds, const Gemm g, const Sched& S, const Epi& E) {
    const int tid = threadIdx.x, wid = __builtin_amdgcn_readfirstlane(tid >> 6), lane = tid & 63, wr = wid >> 2, wc = wid & 3, fr = lane & 15, fq = lane >> 4;
    const int K = g.K, nt = K / BK, lda = g.lda;
    unsigned voffA[2], voffB[2];
#pragma unroll
    for (int i = 0; i < 2; ++i) { int R, C; stage_rc(tid * 16 + i * 8192, R, C); const int Rb = Epi::PERM ? ((R & ~31) + perm32(R & 31)) : R;
        voffA[i] = (unsigned)(R * lda + C) * 2u; voffB[i] = (unsigned)(Rb * K + C) * 2u; }
    const size_t kstep = (size_t)(BK * 2);
    const size_t hstepA = (size_t)HALF * lda * 2, hstepB = (size_t)HALF * K * 2;
    const size_t tstepA = 2 * hstepA, tstepB = 2 * hstepB;
    const unsigned ldsw = (unsigned)wid * 1024u;
    const int aoff = lds_byte(wr * 64 + fr, fq * 8), boff = lds_byte(wc * 32 + fr, fq * 8);
#define PG8_SA(b, h) (((b) * 2 + (h)) * HTB)
#define PG8_SB(b, h) ((4 + (b) * 2 + (h)) * HTB)
#define PG8_STAGE(bufoff, gbase, voff) do { _Pragma("unroll") for (int _i = 0; _i < 2; ++_i) \
        __builtin_amdgcn_global_load_lds((const unsigned*)((const char*)(gbase) + (voff)[_i]), (LAS unsigned*)(lds + (bufoff) + ldsw + _i * 8192), 16, 0, 0); } while (0)
#define PG8_LDA(dst, b, h) do { _Pragma("unroll") for (int m = 0; m < 4; ++m) _Pragma("unroll") for (int k = 0; k < 2; ++k) dst[m][k] = *(const LAS bf16x8*)(lds + PG8_SA(b, h) + aoff + m * 2048 + k * 1024); } while (0)
#define PG8_LDB(dst, b, h) do { _Pragma("unroll") for (int n = 0; n < 2; ++n) _Pragma("unroll") for (int k = 0; k < 2; ++k) dst[n][k] = *(const LAS bf16x8*)(lds + PG8_SB(b, h) + boff + n * 2048 + k * 1024); } while (0)
#define PG8_MMA(ai, bj, At, Bt) do { __builtin_amdgcn_s_setprio(1); _Pragma("unroll") for (int m = 0; m < 4; ++m) _Pragma("unroll") for (int n = 0; n < 2; ++n) _Pragma("unroll") for (int k = 0; k < 2; ++k) \
        acc[ai][bj][m][n] = __builtin_amdgcn_mfma_f32_16x16x32_bf16(Bt[n][k], At[m][k], acc[ai][bj][m][n], 0, 0, 0); __builtin_amdgcn_s_setprio(0); } while (0)
#define PG8_WAIT_V(n) asm volatile("s_waitcnt vmcnt(" #n ")" ::: "memory")
#define PG8_WAIT_L(n) asm volatile("s_waitcnt lgkmcnt(" #n ")" ::: "memory")
#define PG8_BAR __builtin_amdgcn_s_barrier()
#define PG8_SCHED __builtin_amdgcn_sched_barrier(0)
    Unit cur, nxt; int ui = 0;
    if (!S.next(0, cur)) return;
    f32x4 acc[2][2][4][2];
#pragma unroll
    for (int a = 0; a < 2; ++a)
#pragma unroll
        for (int b = 0; b < 2; ++b)
#pragma unroll
            for (int m = 0; m < 4; ++m)
#pragma unroll
                for (int n = 0; n < 2; ++n) acc[a][b][m][n] = (f32x4){0.f, 0.f, 0.f, 0.f};
    bf16x8 At[4][2], B0[2][2], B1[2][2];
    const char* cA = (const char*)g.A + (size_t)cur.pm * tstepA; const char* cB = (const char*)g.Bt + (size_t)cur.pn * tstepB;
    if constexpr (SP2) {
    PG8_STAGE(PG8_SB(0, 0), cB, voffB); PG8_STAGE(PG8_SB(0, 1), cB + hstepB, voffB); PG8_STAGE(PG8_SA(0, 0), cA, voffA); PG8_STAGE(PG8_SA(0, 1), cA + hstepA, voffA);
    if (wr == 1) PG8_BAR;
    PG8_WAIT_V(2); PG8_BAR;
    PG8_STAGE(PG8_SB(1, 0), cB + kstep, voffB); PG8_STAGE(PG8_SA(1, 0), cA + kstep, voffA); PG8_STAGE(PG8_SB(1, 1), cB + hstepB + kstep, voffB);
    PG8_WAIT_V(6); PG8_BAR;
    } else {
    PG8_STAGE(PG8_SB(0, 0), cB, voffB); PG8_STAGE(PG8_SA(0, 0), cA, voffA); PG8_STAGE(PG8_SB(0, 1), cB + hstepB, voffB); PG8_STAGE(PG8_SA(0, 1), cA + hstepA, voffA);
    if (wr == 1) PG8_BAR;
    PG8_WAIT_V(4); PG8_BAR;
    PG8_STAGE(PG8_SB(1, 0), cB + kstep, voffB); PG8_STAGE(PG8_SA(1, 0), cA + kstep, voffA); PG8_STAGE(PG8_SB(1, 1), cB + hstepB + kstep, voffB);
    PG8_WAIT_V(6); PG8_BAR;
    }
    for (;;) {
        const bool has_next = S.next(ui + 1, nxt);
        const char* nA = has_next ? (const char*)g.A + (size_t)nxt.pm * tstepA : cA; const char* nB = has_next ? (const char*)g.Bt + (size_t)nxt.pn * tstepB : cB;
        for (int t = 0; t < nt; t += 2) {
            const bool last = (t == nt - 2);
            const char* a1 = cA + (size_t)(t + 1) * kstep;
            const char* a2 = last ? nA : cA + (size_t)(t + 2) * kstep; const char* b2 = last ? nB : cB + (size_t)(t + 2) * kstep;
            const char* a3 = a2 + kstep; const char* b3 = b2 + kstep;
            if constexpr (SP2) {
            PG8_LDB(B0, 0, 0); PG8_LDB(B1, 0, 1); PG8_SCHED; PG8_LDA(At, 0, 0); PG8_STAGE(PG8_SA(1, 1), a1 + hstepA, voffA);
            PG8_WAIT_V(8); PG8_WAIT_L(0); PG8_BAR; PG8_MMA(0, 0, At, B0); PG8_MMA(0, 1, At, B1); PG8_BAR; PG8_SCHED;
            PG8_LDA(At, 0, 1); PG8_STAGE(PG8_SB(0, 0), b2, voffB); PG8_STAGE(PG8_SB(0, 1), b2 + hstepB, voffB); PG8_STAGE(PG8_SA(0, 0), a2, voffA);
            PG8_WAIT_V(8); PG8_WAIT_L(0); PG8_BAR; PG8_MMA(1, 0, At, B0); PG8_MMA(1, 1, At, B1); PG8_BAR; PG8_SCHED;
            PG8_LDB(B0, 1, 0); PG8_LDB(B1, 1, 1); PG8_SCHED; PG8_LDA(At, 1, 0); PG8_STAGE(PG8_SA(0, 1), a2 + hstepA, voffA);
            PG8_WAIT_V(8); PG8_WAIT_L(0); PG8_BAR; PG8_MMA(0, 0, At, B0); PG8_MMA(0, 1, At, B1); PG8_BAR; PG8_SCHED;
            PG8_LDA(At, 1, 1); PG8_STAGE(PG8_SB(1, 0), b3, voffB); PG8_STAGE(PG8_SB(1, 1), b3 + hstepB, voffB); PG8_STAGE(PG8_SA(1, 0), a3, voffA);
            PG8_WAIT_V(8); PG8_WAIT_L(0); PG8_BAR; PG8_MMA(1, 0, At, B0); PG8_MMA(1, 1, At, B1); PG8_BAR; PG8_SCHED;
            } else {
            PG8_LDB(B0, 0, 0); PG8_SCHED; PG8_LDA(At, 0, 0); PG8_STAGE(PG8_SA(1, 1), a1 + hstepA, voffA);
            PG8_WAIT_L(8); PG8_BAR; PG8_WAIT_L(0); PG8_MMA(0, 0, At, B0); PG8_BAR; PG8_SCHED;
            PG8_LDB(B1, 0, 1); PG8_STAGE(PG8_SB(0, 0), b2, voffB);
            PG8_BAR; PG8_WAIT_L(0); PG8_MMA(0, 1, At, B1); PG8_BAR;
            PG8_LDA(At, 0, 1); PG8_STAGE(PG8_SA(0, 0), a2, voffA);
            PG8_BAR; PG8_WAIT_L(0); PG8_MMA(1, 0, At, B0); PG8_BAR; PG8_SCHED;
            PG8_STAGE(PG8_SB(0, 1), b2 + hstepB, voffB);
            PG8_WAIT_V(6); PG8_BAR; PG8_MMA(1, 1, At, B1); PG8_BAR;
            PG8_LDB(B0, 1, 0); PG8_SCHED; PG8_LDA(At, 1, 0); PG8_STAGE(PG8_SA(0, 1), a2 + hstepA, voffA);
            PG8_WAIT_L(8); PG8_BAR; PG8_WAIT_L(0); PG8_MMA(0, 0, At, B0); PG8_BAR; PG8_SCHED;
            PG8_LDB(B1, 1, 1); PG8_STAGE(PG8_SB(1, 0), b3, voffB);
            PG8_BAR; PG8_WAIT_L(0); PG8_MMA(0, 1, At, B1); PG8_BAR;
            PG8_LDA(At, 1, 1); PG8_STAGE(PG8_SA(1, 0), a3, voffA);
            PG8_BAR; PG8_WAIT_L(0); PG8_MMA(1, 0, At, B0); PG8_BAR; PG8_SCHED;
            PG8_STAGE(PG8_SB(1, 1), b3 + hstepB, voffB);
            PG8_WAIT_V(6); PG8_BAR; PG8_MMA(1, 1, At, B1); PG8_BAR;
            }
        }
        if (wr == 0) PG8_BAR;
        E(acc, cur, wr, wc, fr, fq);
        if constexpr (Epi::POST) { asm volatile("s_waitcnt vmcnt(0)" ::: "memory"); PG8_BAR; asm volatile("" ::: "memory"); E.post(cur, tid); }
        if (!has_next) break;
#pragma unroll
        for (int a = 0; a < 2; ++a)
#pragma unroll
            for (int b = 0; b < 2; ++b)
#pragma unroll
                for (int m = 0; m < 4; ++m)
#pragma unroll
                    for (int n = 0; n < 2; ++n) acc[a][b][m][n] = (f32x4){0.f, 0.f, 0.f, 0.f};
        cur = nxt; cA = nA; cB = nB; ++ui;
        if (wr == 1) PG8_BAR;
    }
    PG8_WAIT_V(0);
    PG8_BAR;
#undef PG8_SA
#undef PG8_SB
#undef PG8_STAGE
#undef PG8_LDA
#undef PG8_LDB
#undef PG8_MMA
#undef PG8_WAIT_V
#undef PG8_WAIT_L
#undef PG8_BAR
#undef PG8_SCHED
}
}

namespace att {
constexpr int NW = 8, QBLK = 32, KVBLK = 64, QB = NW * QBLK, DV = 128;
constexpr int SHM_V = KVBLK * DV * 2;
#define SBAR() __builtin_amdgcn_sched_barrier(0)
__device__ __forceinline__ int v_st(int k, int c) { const int kk = (k & ~0xC) | ((k & 4) << 1) | ((k & 8) >> 1); return ((kk >> 3) * 4 + (c >> 5)) * 512 + ((kk & 7) * 32 + (c & 31)) * 2; }
__device__ __forceinline__ int v_rd_base(int lane) { return ((lane & 3) << 3) | (((lane >> 2) & 3) << 6) | (((lane >> 4) & 1) << 5) | (((lane >> 5) & 1) << 8); }
constexpr int v_rd_off(int d0, int ks, int half) { return d0 * 512 + ks * 4096 + half * 2048; }
__device__ __forceinline__ int crow(int r, int hi) { return (r & 3) + 8 * (r >> 2) + 4 * hi; }
__device__ __forceinline__ bf16x8 load8(const bf16_t* p) { return *reinterpret_cast<const bf16x8*>(p); }

__device__ __forceinline__ void mask_tile(f32x16& p0, f32x16& p1, int dq) {
    const float NEG = -__builtin_inff();
#pragma unroll
    for (int r = 0; r < 16; ++r) {
        const int c = (r & 3) + 8 * (r >> 2);
        if (dq - c < 0) p0[r] = NEG;
        if (dq - c - 32 < 0) p1[r] = NEG;
    }
}
constexpr float THR = 8.f;
__device__ __forceinline__ void partialSM(f32x16& p0, f32x16& p1, float& m_reg, float& mn, float& alpha, float SCALE) {
    float pmax = p0[0];
#pragma unroll
    for (int r = 1; r < 16; ++r) pmax = fmaxf(pmax, p0[r]);
#pragma unroll
    for (int r = 0; r < 16; ++r) pmax = fmaxf(pmax, p1[r]);
    { auto rr = __builtin_amdgcn_permlane32_swap(__float_as_uint(pmax), __float_as_uint(pmax), false, false);
      pmax = fmaxf(__uint_as_float(rr[0]), __uint_as_float(rr[1])); }
    const float C2 = 1.4426950408889634f * SCALE;
    if (__builtin_expect(__all((pmax - m_reg) * SCALE <= THR), 1)) { mn = m_reg; alpha = 1.f; }
    else { mn = fmaxf(m_reg, pmax); alpha = __builtin_amdgcn_exp2f((m_reg - mn) * C2); m_reg = mn; }
    const float mnL = -mn * C2;
#pragma unroll
    for (int r = 0; r < 16; ++r) p0[r] = fmaf(p0[r], C2, mnL);
#pragma unroll
    for (int r = 0; r < 16; ++r) p1[r] = fmaf(p1[r], C2, mnL);
#pragma unroll
    for (int r = 0; r < 16; ++r) p0[r] = __builtin_amdgcn_exp2f(p0[r]);
}
__device__ __forceinline__ void finishSM(f32x16& p0, f32x16& p1, float alpha, float& l_reg, bf16x8& pa0, bf16x8& pa1, bf16x8& pa2, bf16x8& pa3) {
#pragma unroll
    for (int r = 0; r < 16; ++r) p1[r] = __builtin_amdgcn_exp2f(p1[r]);
    float ps = 0;
#pragma unroll
    for (int r = 0; r < 16; ++r) ps += p0[r];
#pragma unroll
    for (int r = 0; r < 16; ++r) ps += p1[r];
    { auto rr = __builtin_amdgcn_permlane32_swap(__float_as_uint(ps), __float_as_uint(ps), false, false);
      ps = __uint_as_float(rr[0]) + __uint_as_float(rr[1]); }
    l_reg = l_reg * alpha + ps;
#define PK4(P, B_, OUT) do { unsigned a0 = cvt_pk_bf16(P[B_+0], P[B_+1]), a1 = cvt_pk_bf16(P[B_+2], P[B_+3]);                          \
        unsigned b0 = cvt_pk_bf16(P[B_+4], P[B_+5]), b1 = cvt_pk_bf16(P[B_+6], P[B_+7]);                                             \
        auto r0 = __builtin_amdgcn_permlane32_swap(a0, b0, false, false); auto r1 = __builtin_amdgcn_permlane32_swap(a1, b1, false, false); \
        u32x4 w = {r0[0], r1[0], r0[1], r1[1]}; OUT = *reinterpret_cast<bf16x8*>(&w); } while (0)
    PK4(p0, 0, pa0); PK4(p0, 8, pa1); PK4(p1, 0, pa2); PK4(p1, 8, pa3);
#undef PK4
}
template <int DQK_, int QS_, int KS_, int VS_, int OS_> struct Cfg {
    static constexpr float SCALE = DQK_ == 192 ? 0.07216878364870322f : 0.08838834764831845f;
    static constexpr int DQK = DQK_, QS = QS_, KS = KS_, VS = VS_, OS = OS_;
    static constexpr int RB = DQK * 2 + 16;
    static constexpr int SHM_K = KVBLK * RB;
    static constexpr int NQ = DQK / 16;
    static constexpr int NCH = DQK / 8;
    static constexpr int KST = DQK / 64;
    static constexpr int NQR = 8;
    static constexpr int QL_OFF = 2 * SHM_V + 2 * SHM_K + NW * 64 * 4;
};
#define KSWZ(C, row, colB) ((row) * C::RB + (colB))
template <class C, int KB>
__device__ __forceinline__ void qkt(f32x16& p0, f32x16& p1, const char* K_lds, int r32, int hi, const bf16x8* qr, const char* ql) {
    p0 = f32x16{}; p1 = f32x16{};
    const char* kb[4];
#pragma unroll
    for (int dd = 0; dd < 4; ++dd) kb[dd] = K_lds + KB * C::SHM_K + KSWZ(C, r32, (dd * 16 + hi * 8) * 2);
#pragma unroll
    for (int d0 = 0; d0 < C::NQ; ++d0) { const char* a = kb[d0 & 3] + (d0 >> 2) * 128;
        bf16x8 b0 = *reinterpret_cast<const bf16x8*>(a);
        bf16x8 b1 = *reinterpret_cast<const bf16x8*>(a + 32 * C::RB);
        bf16x8 qf; if (d0 < C::NQR) qf = qr[d0]; else qf = *reinterpret_cast<const bf16x8*>(ql + (d0 - C::NQR) * 1024);
        p0 = __builtin_amdgcn_mfma_f32_32x32x16_bf16(b0, qf, p0, 0, 0, 0);
        p1 = __builtin_amdgcn_mfma_f32_32x32x16_bf16(b1, qf, p1, 0, 0, 0);
        if ((d0 & 3) == 3 && d0 + 1 < C::NQ) SBAR(); }
}
template <int VB>
__device__ __forceinline__ void pv_tile(f32x16* o, int vb0, bf16x8 pa0, bf16x8 pa1, bf16x8 pa2, bf16x8 pa3) {
#define TRRD(dst, off) asm volatile("ds_read_b64_tr_b16 %0, %1 offset:%2" : "=&v"(dst) : "v"(vb0), "i"(off) : "memory")
#define PV_D0(d0) do { s16x4 l0, l1, l2, l3, h0, h1, h2, h3; constexpr int b_ = VB * SHM_V + v_rd_off(d0, 0, 0); \
        TRRD(l0, b_); TRRD(h0, b_ + 2048); TRRD(l1, b_ + 4096); TRRD(h1, b_ + 6144); TRRD(l2, b_ + 8192); TRRD(h2, b_ + 10240); TRRD(l3, b_ + 12288); TRRD(h3, b_ + 14336); \
        asm volatile("s_waitcnt lgkmcnt(0)" ::: "memory"); SBAR(); \
        o[d0] = __builtin_amdgcn_mfma_f32_32x32x16_bf16(pa0, (bf16x8){l0[0], l0[1], l0[2], l0[3], h0[0], h0[1], h0[2], h0[3]}, o[d0], 0, 0, 0);   \
        o[d0] = __builtin_amdgcn_mfma_f32_32x32x16_bf16(pa1, (bf16x8){l1[0], l1[1], l1[2], l1[3], h1[0], h1[1], h1[2], h1[3]}, o[d0], 0, 0, 0);   \
        o[d0] = __builtin_amdgcn_mfma_f32_32x32x16_bf16(pa2, (bf16x8){l2[0], l2[1], l2[2], l2[3], h2[0], h2[1], h2[2], h2[3]}, o[d0], 0, 0, 0);   \
        o[d0] = __builtin_amdgcn_mfma_f32_32x32x16_bf16(pa3, (bf16x8){l3[0], l3[1], l3[2], l3[3], h3[0], h3[1], h3[2], h3[3]}, o[d0], 0, 0, 0); } while (0)
    PV_D0(0); PV_D0(1); PV_D0(2); PV_D0(3);
#undef PV_D0
#undef TRRD
}
struct BlockRef { const bf16_t* Q; const bf16_t* K; const bf16_t* V; bf16_t* O; int P0; };
template <class C> struct Seam { bf16x8 qr[C::NQ]; bf16x8 st_v0, st_v1; bf16x8 st_k[C::KST]; };

#define VMW() asm volatile("s_waitcnt vmcnt(0)" ::: "memory")
#define VMWN(n) asm volatile("s_waitcnt vmcnt(%0)" :: "i"(n) : "memory")
#define SLOAD(Kp, Vp, k0) do { S.st_v0 = load8((Vp) + (size_t)((k0) + sr) * C::VS + sc); S.st_v1 = load8((Vp) + (size_t)((k0) + 32 + sr) * C::VS + sc); \
        const bf16_t* kp_ = (Kp) + (size_t)((k0) + (tid >> 3)) * C::KS + (tid & 7) * 8; \
        _Pragma("unroll") for (int i_ = 0; i_ < C::KST; ++i_) S.st_k[i_] = load8(kp_ + 64 * i_); } while (0)
#define SWRITE_K(bf) do { char* kw_ = K_lds + (bf) * C::SHM_K + (tid >> 3) * C::RB + (tid & 7) * 16; \
        _Pragma("unroll") for (int i_ = 0; i_ < C::KST; ++i_) *(bf16x8*)(kw_ + 128 * i_) = S.st_k[i_]; } while (0)
#define SWRITE_V(bf) do { *(bf16x8*)(V_lds + (bf) * SHM_V + vst0) = S.st_v0; *(bf16x8*)(V_lds + (bf) * SHM_V + vst1) = S.st_v1; } while (0)

#define KSRC(tt) (((tt) < NT) ? Kh + (size_t)(tt) * KVBLK * C::KS : nxt.K + (size_t)((tt) - NT) * KVBLK * C::KS)
#define VSRC(tt) (((tt) < NT) ? Vh + (size_t)(tt) * KVBLK * C::VS : nxt.V + (size_t)((tt) - NT) * KVBLK * C::VS)
template <class C>
__device__ __forceinline__ void qxform(Seam<C>& S, int pos, int hi, const float* gq, const float2* rt) {
    if constexpr (C::DQK == 192) {
        int ho = hi * 8; asm volatile("" : "+v"(ho));
        float ss = 0.f;
#pragma unroll
        for (int d0 = 0; d0 < 12; ++d0) { float f[8]; unpack8(__builtin_bit_cast(u32x4, S.qr[d0]), f);
#pragma unroll
            for (int e = 0; e < 8; ++e) ss += f[e] * f[e]; }
        { auto rr = __builtin_amdgcn_permlane32_swap(__float_as_uint(ss), __float_as_uint(ss), false, false); ss = __uint_as_float(rr[0]) + __uint_as_float(rr[1]); }
        const float rstd = __builtin_amdgcn_rsqf(ss * (1.f / 192) + EPS);
#pragma unroll
        for (int d0 = 0; d0 < 8; ++d0) { float f[8], g[8]; unpack8(__builtin_bit_cast(u32x4, S.qr[d0]), f);
            *(f32x4*)g = *(const f32x4*)(gq + d0 * 16 + ho); *(f32x4*)(g + 4) = *(const f32x4*)(gq + d0 * 16 + ho + 4);
#pragma unroll
            for (int e = 0; e < 8; ++e) f[e] = f[e] * rstd * g[e];
            S.qr[d0] = __builtin_bit_cast(bf16x8, pack8f(f)); __builtin_amdgcn_sched_barrier(0); }
#pragma unroll
        for (int d = 0; d < 2; ++d) { float fa[8], fb[8], ga[8], gb[8], cs[16];
            unpack8(__builtin_bit_cast(u32x4, S.qr[8 + d]), fa); unpack8(__builtin_bit_cast(u32x4, S.qr[10 + d]), fb);
            *(f32x4*)ga = *(const f32x4*)(gq + 128 + d * 16 + ho); *(f32x4*)(ga + 4) = *(const f32x4*)(gq + 128 + d * 16 + ho + 4);
            *(f32x4*)gb = *(const f32x4*)(gq + 160 + d * 16 + ho); *(f32x4*)(gb + 4) = *(const f32x4*)(gq + 160 + d * 16 + ho + 4);
            const f32x4* r4 = (const f32x4*)(rt + (size_t)pos * 32 + d * 16 + ho);
#pragma unroll
            for (int e = 0; e < 4; ++e) *(f32x4*)(cs + 4 * e) = r4[e];
#pragma unroll
            for (int e = 0; e < 8; ++e) { const float a = fa[e] * rstd * ga[e], b = fb[e] * rstd * gb[e], c = cs[2 * e], sn = cs[2 * e + 1];
                fa[e] = a * c - b * sn; fb[e] = b * c + a * sn; }
            S.qr[8 + d] = __builtin_bit_cast(bf16x8, pack8f(fa)); S.qr[10 + d] = __builtin_bit_cast(bf16x8, pack8f(fb)); __builtin_amdgcn_sched_barrier(0); }
    } else {
        int ho = hi * 8; asm volatile("" : "+v"(ho));
        float ss = 0.f;
#pragma unroll
        for (int d0 = 0; d0 < 8; ++d0) { float f[8]; unpack8(__builtin_bit_cast(u32x4, S.qr[d0]), f);
#pragma unroll
            for (int e = 0; e < 8; ++e) ss += f[e] * f[e]; }
        { auto rr = __builtin_amdgcn_permlane32_swap(__float_as_uint(ss), __float_as_uint(ss), false, false); ss = __uint_as_float(rr[0]) + __uint_as_float(rr[1]); }
        const float rstd = __builtin_amdgcn_rsqf(ss * (1.f / 128) + EPS);
#pragma unroll
        for (int d0 = 0; d0 < 8; ++d0) { float f[8], g[8]; unpack8(__builtin_bit_cast(u32x4, S.qr[d0]), f);
            *(f32x4*)g = *(const f32x4*)(gq + d0 * 16 + ho); *(f32x4*)(g + 4) = *(const f32x4*)(gq + d0 * 16 + ho + 4);
#pragma unroll
            for (int e = 0; e < 8; ++e) f[e] = f[e] * rstd * g[e];
            S.qr[d0] = __builtin_bit_cast(bf16x8, pack8f(f)); __builtin_amdgcn_sched_barrier(0); }
    }
}
template <class C>
__device__ __forceinline__ void prime(const BlockRef& cur, char* lds, Seam<C>& S) {
    int tid_ = threadIdx.x; asm volatile("" : "+v"(tid_));
    const int tid = tid_, wid = __builtin_amdgcn_readfirstlane(tid >> 6), lane = tid & 63, r32 = lane & 31, hi = lane >> 5;
    const int sr = tid >> 4, sc = (tid & 15) * 8, vst0 = v_st(sr, sc), vst1 = v_st(32 + sr, sc); char* V_lds = lds; char* K_lds = lds + 2 * SHM_V;
#pragma unroll
    for (int d0 = 0; d0 < C::NQ; ++d0) S.qr[d0] = load8(cur.Q + (size_t)(wid * QBLK + r32) * C::QS + d0 * 16 + hi * 8);
    SLOAD(cur.K, cur.V, 0); VMW(); SWRITE_K(0); SWRITE_V(0);
    SLOAD(cur.K, cur.V, KVBLK);
    __syncthreads();
}
template <class C>
__device__ __forceinline__ void block(const BlockRef& cur, const BlockRef& nxt, int skv, char* lds, Seam<C>& S, const float* gq, const float2* rt) {
    int tid_ = threadIdx.x; asm volatile("" : "+v"(tid_));
    const int tid = tid_, wid = __builtin_amdgcn_readfirstlane(tid >> 6), lane = tid & 63, r32 = lane & 31, hi = lane >> 5;
    int j_hi = (cur.P0 + QB - 1) / KVBLK + 1; if (j_hi > skv / KVBLK) j_hi = skv / KVBLK;
    const int NT = j_hi;
    const int qlo = cur.P0 + wid * QBLK, qm = qlo + r32 - 4 * hi;
    char* V_lds = lds; char* K_lds = lds + 2 * SHM_V;
    float* ws = (float*)(lds + 2 * SHM_V + 2 * C::SHM_K) + wid * 64; float* li_l = ws, * al_l = ws + 32;
    float m_reg = -1e30f, l_reg = 0; f32x16 o[4] = {};
    const int sr = tid >> 4, sc = (tid & 15) * 8, vst0 = v_st(sr, sc), vst1 = v_st(32 + sr, sc);
    const int vb0 = (int)(uintptr_t)V_lds + v_rd_base(lane);
    const bf16_t* Kh = cur.K; const bf16_t* Vh = cur.V;
    char* ql = lds + C::QL_OFF + wid * 4096 + lane * 16;
    qxform<C>(S, cur.P0 + wid * QBLK + r32, hi, gq, rt);
#pragma unroll
    for (int d0 = C::NQR; d0 < C::NQ; ++d0) *(bf16x8*)(ql + (d0 - C::NQR) * 1024) = S.qr[d0];
    constexpr float SCALE = C::SCALE, C2 = 1.4426950408889634f * C::SCALE;
#define TRRD1(dst, off) asm volatile("ds_read_b64_tr_b16 %0, %1 offset:%2" : "=&v"(dst) : "v"(vb0), "i"(off) : "memory")
#define TR_ISSUE(V, B, d0) do { constexpr int b_ = (B) * SHM_V + v_rd_off(d0, 0, 0); TRRD1(V[0], b_); TRRD1(V[1], b_ + 2048); TRRD1(V[2], b_ + 4096); TRRD1(V[3], b_ + 6144); \
        TRRD1(V[4], b_ + 8192); TRRD1(V[5], b_ + 10240); TRRD1(V[6], b_ + 12288); TRRD1(V[7], b_ + 14336); } while (0)
#define WAITL(n) do { asm volatile("s_waitcnt lgkmcnt(%0)" :: "i"(n) : "memory"); SBAR(); } while (0)
#define VF(V, k) (bf16x8){V[2*(k)][0], V[2*(k)][1], V[2*(k)][2], V[2*(k)][3], V[2*(k)+1][0], V[2*(k)+1][1], V[2*(k)+1][2], V[2*(k)+1][3]}
#define PV_MMA(V, d0) do { o[d0] = __builtin_amdgcn_mfma_f32_32x32x16_bf16(pa0, VF(V, 0), o[d0], 0, 0, 0); o[d0] = __builtin_amdgcn_mfma_f32_32x32x16_bf16(pa1, VF(V, 1), o[d0], 0, 0, 0); \
        o[d0] = __builtin_amdgcn_mfma_f32_32x32x16_bf16(pa2, VF(V, 2), o[d0], 0, 0, 0); o[d0] = __builtin_amdgcn_mfma_f32_32x32x16_bf16(pa3, VF(V, 3), o[d0], 0, 0, 0); SBAR(); } while (0)
#define STEP(t, B) do { f32x16 p0, p1; bf16x8 pa0, pa1, pa2, pa3; float alpha;                                             \
        SBAR(); qkt<C, B>(p0, p1, K_lds, r32, hi, S.qr, ql); SBAR();                                                       \
        s16x4 vA_[8], vB_[8]; TR_ISSUE(vA_, B, 0);                                                                         \
        if ((t) == NT - 1) { _Pragma("unroll") for (int d0 = 0; d0 < C::NQ; ++d0) S.qr[d0] = load8(nxt.Q + (size_t)(wid * QBLK + r32) * C::QS + d0 * 16 + hi * 8); } \
        { const int kb_ = (t) * KVBLK; if (kb_ + KVBLK - 1 > qlo) mask_tile(p0, p1, qm - kb_); }                           \
        { float pmax = p0[0];                                                                                              \
          _Pragma("unroll") for (int r = 1; r < 16; ++r) pmax = fmaxf(pmax, p0[r]);                                        \
          _Pragma("unroll") for (int r = 0; r < 16; ++r) pmax = fmaxf(pmax, p1[r]);                                        \
          { auto rr = __builtin_amdgcn_permlane32_swap(__float_as_uint(pmax), __float_as_uint(pmax), false, false);        \
            pmax = fmaxf(__uint_as_float(rr[0]), __uint_as_float(rr[1])); }                                                \
          float mn;                                                                                                        \
          if (__builtin_expect(__all((pmax - m_reg) * SCALE <= THR), 1)) { mn = m_reg; alpha = 1.f; }                      \
          else { mn = fmaxf(m_reg, pmax); alpha = __builtin_amdgcn_exp2f((m_reg - mn) * C2); m_reg = mn; }                 \
          const float mnL = -mn * C2;                                                                                      \
          _Pragma("unroll") for (int r = 0; r < 16; ++r) p0[r] = __builtin_amdgcn_exp2f(fmaf(p0[r], C2, mnL));             \
          _Pragma("unroll") for (int r = 0; r < 16; ++r) p1[r] = __builtin_amdgcn_exp2f(fmaf(p1[r], C2, mnL));             \
          float ps = 0;                                                                                                    \
          _Pragma("unroll") for (int r = 0; r < 16; ++r) ps += p0[r];                                                      \
          _Pragma("unroll") for (int r = 0; r < 16; ++r) ps += p1[r];                                                      \
          { auto rr = __builtin_amdgcn_permlane32_swap(__float_as_uint(ps), __float_as_uint(ps), false, false);            \
            ps = __uint_as_float(rr[0]) + __uint_as_float(rr[1]); }                                                        \
          l_reg = l_reg * alpha + ps; }                                                                                    \
        PK4(p0, 0, pa0); PK4(p0, 8, pa1); PK4(p1, 0, pa2); PK4(p1, 8, pa3);                                                \
        if (__any(alpha < 1.f)) { if (hi == 0) al_l[r32] = alpha; asm volatile("s_waitcnt lgkmcnt(0)" ::: "memory");       \
            _Pragma("unroll") for (int d_ = 0; d_ < 4; ++d_) _Pragma("unroll") for (int r = 0; r < 16; ++r) o[d_][r] *= al_l[crow(r, hi)]; } \
        SBAR(); TR_ISSUE(vB_, B, 1); WAITL(8); PV_MMA(vA_, 0); TR_ISSUE(vA_, B, 2); WAITL(8); PV_MMA(vB_, 1);                \
        TR_ISSUE(vB_, B, 3); WAITL(8); PV_MMA(vA_, 2); WAITL(0); PV_MMA(vB_, 3); SBAR();                                     \
        VMW(); SWRITE_K((B) ^ 1); SWRITE_V((B) ^ 1);                                                                       \
        __syncthreads();                                                                                                   \
        SLOAD(KSRC((t) + 2), VSRC((t) + 2), 0); } while (0)
#define PK4(P, B_, OUT) do { unsigned a0 = cvt_pk_bf16(P[B_+0], P[B_+1]), a1 = cvt_pk_bf16(P[B_+2], P[B_+3]);                          \
        unsigned b0 = cvt_pk_bf16(P[B_+4], P[B_+5]), b1 = cvt_pk_bf16(P[B_+6], P[B_+7]);                                             \
        auto r0 = __builtin_amdgcn_permlane32_swap(a0, b0, false, false); auto r1 = __builtin_amdgcn_permlane32_swap(a1, b1, false, false); \
        u32x4 w = {r0[0], r1[0], r0[1], r1[1]}; OUT = *reinterpret_cast<bf16x8*>(&w); } while (0)
    for (int t = 0; t < NT; t += 2) { STEP(t, 0); STEP(t + 1, 1); }
#undef STEP
#undef PK4
#undef TRRD1
#undef TR_ISSUE
#undef WAITL
#undef VF
#undef PV_MMA
    if (hi == 0) li_l[r32] = l_reg; asm volatile("s_waitcnt lgkmcnt(0)" ::: "memory");
    float rli[16];
#pragma unroll
    for (int r = 0; r < 16; ++r) rli[r] = __builtin_amdgcn_rcpf(li_l[crow(r, hi)]);
    bf16_t* Ow = cur.O + (size_t)(wid * QBLK) * C::OS;
#pragma unroll
    for (int r = 0; r < 16; ++r) { const int orow = crow(r, hi);
#pragma unroll
        for (int d0 = 0; d0 < 4; ++d0) { const float v = o[d0][r] * rli[r];
            const float vn = __shfl_xor(v, 1);
            if ((r32 & 1) == 0) *(unsigned*)(Ow + (size_t)orow * C::OS + d0 * 32 + r32) = cvt_pk_bf16(v, vn); } }
    asm volatile("s_waitcnt lgkmcnt(0)" ::: "memory");
}
#undef KSRC
#undef VSRC
#undef VMW
#undef VMWN
#undef SLOAD
#undef SWRITE_K
#undef SWRITE_V
#undef SBAR
}


#define XB_TMO      128
#define XB_XCNT(j)  (256  + 64 * (j))
#define XB_XSUB(j)  (1280 + 64 * (j))
#define XB_XGEN(j)  (2304 + 64 * (j))
#define XB_TOP      3328
#define XB_TOPGEN   3392
#define XCD_BAR_WORDS 3456
#define XB_SPIN_CAP (1u << 22)
__device__ __forceinline__ unsigned xb_ld(unsigned* p)              { return __hip_atomic_load(p, __ATOMIC_RELAXED, __HIP_MEMORY_SCOPE_AGENT); }
__device__ __forceinline__ unsigned xb_add(unsigned* p, unsigned v) { return __hip_atomic_fetch_add(p, v, __ATOMIC_RELAXED, __HIP_MEMORY_SCOPE_AGENT); }
__device__ __forceinline__ unsigned xb_xcc_id() { return (unsigned)__builtin_amdgcn_s_getreg((3 << 11) | 20) & 0xFu; }
#define XB_SPIN(cond, bar) do { unsigned _sp = 0; while (cond) { __builtin_amdgcn_s_sleep(1); \
    if ((++_sp & 255u) == 0u) { if (xb_ld(&(bar)[XB_TMO])) break; if (_sp > XB_SPIN_CAP) { atomicAdd(&(bar)[XB_TMO], 1u); break; } } } } while (0)
struct XcdBarrier { unsigned* bar; unsigned x; volatile LAS unsigned* st; };
__device__ __forceinline__ XcdBarrier xcd_barrier_post(unsigned* bar, volatile LAS unsigned* st) {
    XcdBarrier b; b.bar = bar; b.x = xb_xcc_id(); b.st = st;
    if (threadIdx.x == 0) (void)xb_add(&bar[XB_XCNT(b.x)], 1u);
    return b;
}
__device__ __forceinline__ void xcd_barrier_complete(unsigned* bar, unsigned x, unsigned& nloc, unsigned& nx) {
    const unsigned G = gridDim.x * gridDim.y * gridDim.z;
    unsigned sum, cnt, mine, sp = 0u;
    for (;;) {
        sum = 0u; cnt = 0u; mine = 0u;
#pragma unroll
        for (unsigned j = 0; j < 16; ++j) { const unsigned c = xb_ld(&bar[XB_XCNT(j)]); sum += c; cnt += (c > 0u) ? 1u : 0u; mine = (j == x) ? c : mine; }
        if (sum == G) break;
        __builtin_amdgcn_s_sleep(1);
        if ((++sp & 255u) == 0u) { if (xb_ld(&bar[XB_TMO])) break; if (sp > XB_SPIN_CAP) { atomicAdd(&bar[XB_TMO], 1u); break; } }
    }
    nloc = mine > 0u ? mine : 1u; nx = cnt > 0u ? cnt : 1u;
}
__device__ __forceinline__ void xcd_barrier(const XcdBarrier& b) {
    asm volatile("s_waitcnt vmcnt(0)" ::: "memory");
    __syncthreads();
    if (threadIdx.x == 0) {
        unsigned* bar = b.bar;
        __builtin_amdgcn_s_waitcnt(0);
        unsigned nloc = b.st[0], nx = b.st[1];
        if (nloc == 0u) { xcd_barrier_complete(bar, b.x, nloc, nx); b.st[0] = nloc; b.st[1] = nx; }
        const unsigned old = xb_add(&bar[XB_XSUB(b.x)], 1u);
        const unsigned gen = old / nloc;
        if (old + 1u == (gen + 1u) * nloc) {
            __builtin_amdgcn_fence(__ATOMIC_RELEASE, "agent");
            asm volatile("s_waitcnt vmcnt(0)" ::: "memory");
            const unsigned og = xb_add(&bar[XB_TOP], 1u);
            const unsigned tg = og / nx;
            if (og + 1u == (tg + 1u) * nx) xb_add(&bar[XB_TOPGEN], 1u);
            else XB_SPIN(xb_ld(&bar[XB_TOPGEN]) == tg, bar);
            __builtin_amdgcn_fence(__ATOMIC_ACQUIRE, "agent");
            xb_add(&bar[XB_XGEN(b.x)], 1u);
            asm volatile("s_waitcnt vmcnt(0)" ::: "memory");
        } else {
            XB_SPIN(xb_ld(&bar[XB_XGEN(b.x)]) == gen, bar);
            __builtin_amdgcn_fence(__ATOMIC_ACQUIRE, "agent");
            asm volatile("s_waitcnt vmcnt(0)" ::: "memory");
        }
    }
    __syncthreads();
}

struct Frame {
    LAS unsigned char* lds;
    int tid, lane, wave, vcu, G;
};

__device__ __forceinline__ void p0_transpose_item(const float* W, int K, int N, bf16_t* WT, LAS float* scr, int item, int lane, const float* gk = nullptr) {
    const int nblk = N / 32, kb = item / nblk, nb = item % nblk, k0 = 64 * kb, n0 = 32 * nb;
    float tv_[32];
#pragma unroll
    for (int i = 0; i < 32; ++i) tv_[i] = W[(size_t)(k0 + 2 * i + (lane >> 5)) * N + n0 + (lane & 31)];
    if (gk) {
#pragma unroll
        for (int i = 0; i < 32; ++i) tv_[i] *= gk[k0 + 2 * i + (lane >> 5)]; }
#pragma unroll
    for (int i = 0; i < 32; ++i) scr[(2 * i + (lane >> 5)) * 33 + (lane & 31)] = tv_[i];
    LDS_WAIT(); asm volatile("" ::: "memory");
    const int c = lane & 7;
#pragma unroll
    for (int j = 0; j < 4; ++j) { const int n = (lane >> 3) + 8 * j; const LAS float* s = scr + (8 * c) * 33 + n;
        u32x4 o; o.x = pk2(s[0 * 33], s[1 * 33]); o.y = pk2(s[2 * 33], s[3 * 33]); o.z = pk2(s[4 * 33], s[5 * 33]); o.w = pk2(s[6 * 33], s[7 * 33]);
        *(u32x4*)(WT + (size_t)(n0 + n) * K + k0 + 8 * c) = o; }
    LDS_WAIT(); asm volatile("" ::: "memory");
}
__device__ __forceinline__ void rms_row_2048(const float* xrow, const float* g, bf16_t* orow, int lane) {
    const f32x4* xr = (const f32x4*)xrow + lane; const f32x4* gr = (const f32x4*)g + lane;
    f32x4 v[8]; float s = 0.f;
#pragma unroll
    for (int j = 0; j < 8; ++j) { v[j] = xr[64 * j]; s += (v[j].x * v[j].x + v[j].y * v[j].y) + (v[j].z * v[j].z + v[j].w * v[j].w); }
    const float rstd = __builtin_amdgcn_rsqf(wave_sum(s) * (1.f / DM) + EPS);
    u32x2* o8 = (u32x2*)orow + lane;
#pragma unroll
    for (int j = 0; j < 8; ++j) { const f32x4 gg = gr[64 * j]; u32x2 w; w.x = pk2(v[j].x * rstd * gg.x, v[j].y * rstd * gg.y); w.y = pk2(v[j].z * rstd * gg.z, v[j].w * rstd * gg.w); o8[64 * j] = w; }
}

__device__ __forceinline__ void rms_row2_2048(const float* xa, const float* xb, const float* g, bf16_t* oa, bf16_t* ob, int lane) {
    const f32x4* ra = (const f32x4*)xa + lane; const f32x4* rb = (const f32x4*)xb + lane; const f32x4* gr = (const f32x4*)g + lane;
    f32x4 va[8], vb[8]; float sa = 0.f, sb = 0.f;
#pragma unroll
    for (int j = 0; j < 8; ++j) { va[j] = ra[64 * j]; vb[j] = rb[64 * j]; }
#pragma unroll
    for (int j = 0; j < 8; ++j) { sa += (va[j].x * va[j].x + va[j].y * va[j].y) + (va[j].z * va[j].z + va[j].w * va[j].w); sb += (vb[j].x * vb[j].x + vb[j].y * vb[j].y) + (vb[j].z * vb[j].z + vb[j].w * vb[j].w); }
    const float rsa = __builtin_amdgcn_rsqf(wave_sum(sa) * (1.f / DM) + EPS), rsb = __builtin_amdgcn_rsqf(wave_sum(sb) * (1.f / DM) + EPS);
    u32x2* o8a = (u32x2*)oa + lane; u32x2* o8b = (u32x2*)ob + lane;
#pragma unroll
    for (int j = 0; j < 8; ++j) { const f32x4 gg = gr[64 * j]; u32x2 w;
        w.x = pk2(va[j].x * rsa * gg.x, va[j].y * rsa * gg.y); w.y = pk2(va[j].z * rsa * gg.z, va[j].w * rsa * gg.w); o8a[64 * j] = w;
        w.x = pk2(vb[j].x * rsb * gg.x, vb[j].y * rsb * gg.y); w.y = pk2(vb[j].z * rsb * gg.z, vb[j].w * rsb * gg.w); o8b[64 * j] = w; }
}
#define O ((bf16_t*)(wsb + WS_KVR))
#define Z ((const bf16_t*)(wsb + WS_Z))
#define rt ((const float2*)(wsb + WS_ROPE))
#define KF ((bf16_t*)(wsb + WS_KF))
__device__ __forceinline__ void kv_post(unsigned char* wsb, const float* gk, const pg8::Unit& u, int tid_in) {
        int tid = tid_in; asm volatile("" : "+v"(tid));
        const int j = tid & 7, h = u.pn;
#pragma unroll 1
        for (int ps = 0; ps < 4; ++ps) {
            const int row = u.pm * 256 + (tid >> 3) + 64 * ps; const int pos = row & (SEQ - 1);
            const bf16_t* kp = O + (size_t)row * 2048 + h * 256 + j * 8;
            const u32x4 w0 = *(const u32x4*)kp, w1 = *(const u32x4*)(kp + 64), w2 = *(const u32x4*)(Z + (size_t)row * ZC + C_KR + j * 8);
            const f32x4* r4 = (const f32x4*)(rt + (size_t)pos * 32 + (j & 3) * 8);
            const f32x4 r0 = r4[0], r1 = r4[1], r2 = r4[2], r3 = r4[3];
            float v[24];
            unpack8(w0, v); unpack8(w1, v + 8); unpack8(w2, v + 16);
            float s2 = 0.f;
#pragma unroll
            for (int e = 0; e < 24; ++e) s2 += v[e] * v[e];
            s2 += __shfl_xor(s2, 1); s2 += __shfl_xor(s2, 2); s2 += __shfl_xor(s2, 4);
            const float rstd = __builtin_amdgcn_rsqf(s2 * (1.f / 192) + EPS);
#pragma unroll
            for (int c = 0; c < 3; ++c) { const f32x4 ga = *(const f32x4*)(gk + c * 64 + j * 8), gb = *(const f32x4*)(gk + c * 64 + j * 8 + 4);
                v[c * 8 + 0] *= rstd * ga.x; v[c * 8 + 1] *= rstd * ga.y; v[c * 8 + 2] *= rstd * ga.z; v[c * 8 + 3] *= rstd * ga.w;
                v[c * 8 + 4] *= rstd * gb.x; v[c * 8 + 5] *= rstd * gb.y; v[c * 8 + 6] *= rstd * gb.z; v[c * 8 + 7] *= rstd * gb.w; }
            const float cs[8] = {r0.x, r0.z, r1.x, r1.z, r2.x, r2.z, r3.x, r3.z}, sn[8] = {r0.y, r0.w, r1.y, r1.w, r2.y, r2.w, r3.y, r3.w};
#pragma unroll
            for (int e = 0; e < 8; ++e) { const float own = v[16 + e], oth = __shfl_xor(own, 4);
                v[16 + e] = (j < 4) ? (own * cs[e] - oth * sn[e]) : (own * cs[e] + oth * sn[e]); }
            bf16_t* op = KF + (size_t)row * 1536 + h * 192 + j * 8;
            *(u32x4*)op = pack8f(v); *(u32x4*)(op + 64) = pack8f(v + 8); *(u32x4*)(op + 128) = pack8f(v + 16);
        }
    }
#undef O
#undef Z
#undef rt
#undef KF
enum { I_X = 0, I_MEM, I_GMIX, I_WIN, I_GQLAT, I_WQUP, I_GKVLAT, I_WKVUP, I_GQMLA, I_GKMLA, I_WPOOL, I_PSCALE, I_GMEM, I_WMEMKV, I_GQX, I_GKX, I_WO, I_GFFN,
       I_WGATE, I_WUP, I_CONVW, I_CONVB, I_WDOWN };

__device__ __forceinline__ void phase0(const Params& p, Frame& F) {
    unsigned char* ws = p.ws;
    LAS float* scr = (LAS float*)(F.lds + F.wave * 16384);
    const int gw = F.vcu * 8 + F.wave, NGW = F.G * 8, lane = F.lane;
    constexpr int N_IN = (DM / 64) * (IN_COLS / 32), N_Q = (512 / 64) * (1536 / 32), N_KV = (256 / 64) * (2048 / 32), N_MEM = (DM / 64) * (1024 / 32),
                  N_O = (DM / 64) * (DM / 32), N_G = (DM / 64) * (DFF / 32), N_D = (DFF / 64) * (DM / 32);
    constexpr int NITEMS = N_IN + N_Q + N_KV + N_MEM + N_O + 2 * N_G + N_D;
    for (int it = gw; it < NITEMS; it += NGW) {
        int r = it;
        if (r < N_IN) { p0_transpose_item(p.in[I_WIN], DM, IN_COLS, (bf16_t*)(ws + WS_WIN), scr, r, lane); continue; } r -= N_IN;
        if (r < N_Q) { p0_transpose_item(p.in[I_WQUP], 512, 1536, (bf16_t*)(ws + WS_WQ), scr, r, lane, p.in[I_GQLAT]); continue; } r -= N_Q;
        if (r < N_KV) { p0_transpose_item(p.in[I_WKVUP], 256, 2048, (bf16_t*)(ws + WS_WKV), scr, r, lane, p.in[I_GKVLAT]); continue; } r -= N_KV;
        if (r < N_MEM) { p0_transpose_item(p.in[I_WMEMKV], DM, 1024, (bf16_t*)(ws + WS_WMEM), scr, r, lane); continue; } r -= N_MEM;
        if (r < N_O) { p0_transpose_item(p.in[I_WO], DM, DM, (bf16_t*)(ws + WS_WO), scr, r, lane); continue; } r -= N_O;
        if (r < N_G) { p0_transpose_item(p.in[I_WGATE], DM, DFF, (bf16_t*)(ws + WS_WG), scr, r, lane); continue; } r -= N_G;
        if (r < N_G) { p0_transpose_item(p.in[I_WUP], DM, DFF, (bf16_t*)(ws + WS_WU), scr, r, lane); continue; } r -= N_G;
        p0_transpose_item(p.in[I_WDOWN], DFF, DM, (bf16_t*)(ws + WS_WD), scr, r, lane);
    }
    { bf16_t* wt = (bf16_t*)(ws + WS_WIN) + (size_t)IN_COLS * DM; const int n16 = (ZC - IN_COLS) * DM * 2 / 16; const u32x4 z = {0u, 0u, 0u, 0u};
      for (int i = gw * 64 + lane; i < n16; i += NGW * 64) ((u32x4*)wt)[i] = z; }
    { bf16_t* wt = (bf16_t*)(ws + WS_WPOOL); const float* wp = p.in[I_WPOOL]; const float* sc = p.in[I_PSCALE];
      for (int i = gw * 64 + lane; i < 512 * 512; i += NGW * 64) { const int n = i >> 9, k = i & 511; float v = 0.f;
          if ((n >> 7) == (k >> 7)) v = wp[(size_t)(n >> 7) * 16384 + (k & 127) * 128 + (n & 127)] * sc[n];
          wt[i] = (bf16_t)f2bf(v); } }
    { float* ss = (float*)(ws + WS_SS); float* sq_ = (float*)(ws + WS_SSQQ); float* skv_ = (float*)(ws + WS_SSQKV);
      for (int i = gw * 64 + lane; i < T; i += NGW * 64) { ss[i] = 0.f; sq_[i] = 0.f; skv_[i] = 0.f; } }
    { float2* rt = (float2*)(ws + WS_ROPE);
      for (int i = gw * 64 + lane; i < SEQ * 32; i += NGW * 64) { const int pos = i >> 5, k = i & 31; const float ang = (float)pos * p.inv_freq[k];
          float s, c; sincosf(ang, &s, &c); rt[i] = make_float2(c, s); } }
    for (int m = gw; m < T; m += 2 * NGW) { const int m2 = (m + NGW < T) ? m + NGW : m;
        rms_row2_2048(p.in[I_X] + (size_t)m * DM, p.in[I_X] + (size_t)m2 * DM, p.in[I_GMIX], (bf16_t*)(ws + WS_XN) + (size_t)m * DM, (bf16_t*)(ws + WS_XN) + (size_t)m2 * DM, lane); }
    for (int m = gw; m < MROWS; m += NGW) rms_row_2048(p.in[I_MEM] + (size_t)m * DM, p.in[I_GMEM], (bf16_t*)(ws + WS_MEMN) + (size_t)m * DM, lane);
}

__device__ __forceinline__ void phase2(const Params& p, Frame& F) {
    unsigned char* ws = p.ws; const int lane = F.lane;
    const bool split = F.G >= 64; const int gw = (split ? (int)blockIdx.x - 16 : (int)blockIdx.x) * 8 + F.wave, NGW = (split ? F.G - 16 : F.G) * 8;
    const bf16_t* Z = (const bf16_t*)(ws + WS_Z);
    float gq[8], gkv[8], gx[8];
#pragma unroll
    for (int e = 0; e < 8; ++e) { gq[e] = p.in[I_GQLAT][lane * 8 + e]; gkv[e] = p.in[I_GKVLAT][(lane & 31) * 8 + e]; gx[e] = p.in[I_GQX][(lane & 15) * 8 + e]; }
    for (int m = gw; m < T; m += NGW) {
        const bf16_t* zr = Z + (size_t)m * ZC; const int tt = m & (SEQ - 1);
        const int w = 2 << (lane >> 4); const int cnt = (tt + 1) < w ? (tt + 1) : w;
        u32x4 wr_[16];
#pragma unroll
        for (int j = 0; j < 16; ++j) wr_[j] = *(const u32x4*)(zr - (size_t)(j < cnt ? j : 0) * ZC + lane * 8);
        { float s[8], self[8], f[8];
          unpack8(wr_[0], self);
#pragma unroll
          for (int e = 0; e < 8; ++e) s[e] = self[e];
#pragma unroll
          for (int j = 1; j < 16; ++j) { unpack8(wr_[j], f); const float on = j < cnt ? 1.f : 0.f;
#pragma unroll
              for (int e = 0; e < 8; ++e) s[e] = fmaf(on, f[e], s[e]); }
          const float ic = __builtin_amdgcn_rcpf((float)cnt);
#pragma unroll
          for (int e = 0; e < 8; ++e) f[e] = s[e] * ic - self[e];
          *(u32x4*)((bf16_t*)(ws + WS_DP) + (size_t)m * 512 + lane * 8) = pack8f(f); }
    }
}

__device__ __forceinline__ void phase4(const Params& p, Frame& F) {
    unsigned char* ws = p.ws; const int gw = F.vcu * 8 + F.wave, NGW = F.G * 8, lane = F.lane;
    {
    float gkx[8];
#pragma unroll
    for (int e = 0; e < 8; ++e) gkx[e] = p.in[I_GKX][(lane & 15) * 8 + e];
    for (int m = gw; m < MROWS; m += NGW) {
        float v[8]; unpack8(*(const u32x4*)((const bf16_t*)(ws + WS_MKV) + (size_t)m * 1024 + lane * 8), v); float ss = 0.f;
#pragma unroll
        for (int e = 0; e < 8; ++e) ss += v[e] * v[e];
        ss += __shfl_xor(ss, 1); ss += __shfl_xor(ss, 2); ss += __shfl_xor(ss, 4); ss += __shfl_xor(ss, 8);
        const float rstd = __builtin_amdgcn_rsqf(ss * (1.f / 128) + EPS);
#pragma unroll
        for (int e = 0; e < 8; ++e) v[e] = v[e] * rstd * gkx[e];
        *(u32x4*)((bf16_t*)(ws + WS_MKF) + (size_t)m * 512 + lane * 8) = pack8f(v);
    }
    }
    const int head = lane >> 3, j = lane & 7;
    float gq[24], gk[24];
#pragma unroll
    for (int c = 0; c < 3; ++c)
#pragma unroll
        for (int e = 0; e < 8; ++e) { gq[c * 8 + e] = p.in[I_GQMLA][c * 64 + j * 8 + e]; gk[c * 8 + e] = p.in[I_GKMLA][c * 64 + j * 8 + e]; }
    const float2* rt = (const float2*)(ws + WS_ROPE);
    const bf16_t* Z = (const bf16_t*)(ws + WS_Z);
    for (int m0 = gw; m0 < T; m0 += 2 * NGW) {
        f32x4 rr_[2][4]; u32x4 wk_[2][3]; int mm_[2];
#pragma unroll
        for (int u = 0; u < 2; ++u) { const int m = (m0 + u * NGW < T) ? m0 + u * NGW : m0; mm_[u] = m; const int pos = m & (SEQ - 1);
            const f32x4* r4 = (const f32x4*)(rt + (size_t)pos * 32 + (j & 3) * 8);
#pragma unroll
            for (int e = 0; e < 4; ++e) rr_[u][e] = r4[e];
            const bf16_t* kp = (const bf16_t*)(ws + WS_KVR) + (size_t)m * 2048 + head * 256 + j * 8;
            wk_[u][0] = *(const u32x4*)kp; wk_[u][1] = *(const u32x4*)(kp + 64); wk_[u][2] = *(const u32x4*)(Z + (size_t)m * ZC + C_KR + j * 8); }
#pragma unroll
        for (int u = 0; u < 2; ++u) { const int m = mm_[u];
            if (u == 1 && m0 + NGW >= T) break;
            float cs[8], sn[8];
#pragma unroll
            for (int e = 0; e < 4; ++e) { const f32x4 q = rr_[u][e]; cs[2 * e] = q.x; sn[2 * e] = q.y; cs[2 * e + 1] = q.z; sn[2 * e + 1] = q.w; }
#pragma unroll
            for (int which = 1; which < 2; ++which) {
                float v[24];
                { unpack8(wk_[u][0], v); unpack8(wk_[u][1], v + 8); unpack8(wk_[u][2], v + 16); }
                float ss = 0.f;
#pragma unroll
                for (int e = 0; e < 24; ++e) ss += v[e] * v[e];
                ss += __shfl_xor(ss, 1); ss += __shfl_xor(ss, 2); ss += __shfl_xor(ss, 4);
                const float rstd = __builtin_amdgcn_rsqf(ss * (1.f / 192) + EPS);
#pragma unroll
                for (int e = 0; e < 24; ++e) v[e] = v[e] * rstd * (which == 0 ? gq[e] : gk[e]);
#pragma unroll
                for (int e = 0; e < 8; ++e) { const float own = v[16 + e], oth = __shfl_xor(own, 4);
                    v[16 + e] = (j < 4) ? (own * cs[e] - oth * sn[e]) : (own * cs[e] + oth * sn[e]); }
                bf16_t* op = (which == 0) ? ((bf16_t*)(ws + WS_QF) + (size_t)m * 1536 + head * 192 + j * 8) : ((bf16_t*)(ws + WS_KF) + (size_t)m * 1536 + head * 192 + j * 8);
                *(u32x4*)op = pack8f(v); *(u32x4*)(op + 64) = pack8f(v + 8); *(u32x4*)(op + 128) = pack8f(v + 16);
            }
        }
    }
}

#ifndef MLA_DQK
#define MLA_DQK 192
#endif
typedef att::Cfg<MLA_DQK, 1536, 1536, 2048, 2048> CfgMLA;
typedef att::Cfg<128, 2048, 512, 1024, 2048> CfgX;
__device__ __forceinline__ att::BlockRef mla_ref(unsigned char* ws, int L, int pass) {
    const int bh = L >> 4, x = L & 15, b = bh >> 3, h = bh & 7; const int qb = pass ? 31 - x : x;
    att::BlockRef r; const size_t row0 = (size_t)b * SEQ;
    r.Q = (const bf16_t*)(ws + WS_QR) + (row0 + (size_t)qb * 256) * 1536 + h * 192;
    r.K = (const bf16_t*)(ws + WS_KF) + row0 * 1536 + h * 192;
    r.V = (const bf16_t*)(ws + WS_KVR) + row0 * 2048 + h * 256 + 128;
    r.O = (bf16_t*)(ws + WS_Y) + (row0 + (size_t)qb * 256) * 2048 + 512 + h * 128;
    r.P0 = qb * 256; return r;
}
__device__ __forceinline__ att::BlockRef x_ref(unsigned char* ws, int L) {
    const int qb = L & 31, hx = (L >> 5) & 3, b = L >> 7;
    att::BlockRef r; const size_t row0 = (size_t)b * SEQ + (size_t)qb * 256;
    r.Q = (const bf16_t*)(ws + WS_Z) + row0 * ZC + C_MQ + hx * 128;
    r.K = (const bf16_t*)(ws + WS_MKF) + (size_t)b * MEML * 512 + hx * 128;
    r.V = (const bf16_t*)(ws + WS_MKV) + (size_t)b * MEML * 1024 + 512 + hx * 128;
    r.O = (bf16_t*)(ws + WS_Y) + row0 * 2048 + 1536 + hx * 128;
    r.P0 = MEML; return r;
}
__device__ __forceinline__ void phase5(const Params& p, Frame& F, char* lds) {
    unsigned char* ws = p.ws;
    {
        att::Seam<CfgMLA> S;
        const int total = 512; int L = F.vcu, pass = 0;
        if (L < total) {
            att::BlockRef cur = mla_ref(ws, L, 0);
            att::prime<CfgMLA>(cur, lds, S);
            for (;;) {
                int Ln = L, passn = pass + 1; bool last = false;
                if (pass == 1) { passn = 0; if (L + F.G < total) Ln = L + F.G; else last = true; }
                const att::BlockRef nxt = last ? cur : mla_ref(ws, Ln, passn);
                att::block<CfgMLA>(cur, nxt, SEQ, lds, S, p.in[I_GQMLA], (const float2*)(ws + WS_ROPE));
                if (last) break;
                cur = nxt; L = Ln; pass = passn;
            }
        }
    }
    {
        att::Seam<CfgX> S;
        const int total = 512; int L = F.vcu;
        if (L < total) {
            att::BlockRef cur = x_ref(ws, L);
            att::prime<CfgX>(cur, lds, S);
            for (;;) {
                const bool last = !(L + F.G < total); const int Ln = last ? L : L + F.G;
                const att::BlockRef nxt = last ? cur : x_ref(ws, Ln);
                att::block<CfgX>(cur, nxt, MEML, lds, S, p.in[I_GQX], nullptr);
                if (last) break;
                cur = nxt; L = Ln;
            }
        }
    }
}

template <int PH> __device__ __forceinline__ void run_phase(const Params& p, Frame& F, unsigned char* lds) {
    unsigned char* ws = p.ws; typedef pg8::StaticOrder SO;
    if constexpr (PH == 0) { phase0(p, F); }
    if constexpr (PH == 1) {
        { pg8::Gemm g{(const bf16_t*)(ws + WS_XN), (const bf16_t*)(ws + WS_WIN), T, ZC, DM, DM}; SO S; S.init(T, ZC, F.G, (int)blockIdx.x);
          pg8::EpiZ E{(bf16_t*)(ws + WS_Z), ZC, (float*)(ws + WS_SSQQ), (float*)(ws + WS_SSQKV)}; pg8::gemm_phase(F.lds, g, S, E); }
    }
    if constexpr (PH == 2) {
        if (F.G >= 64 && blockIdx.x < 16) {
        { pg8::Gemm g{(const bf16_t*)(ws + WS_MEMN), (const bf16_t*)(ws + WS_WMEM), MROWS, 1024, DM, DM}; SO S; S.init(MROWS, 1024, F.G, (int)blockIdx.x);
          pg8::EpiBf16 E{(bf16_t*)(ws + WS_MKV), 1024}; pg8::gemm_phase(F.lds, g, S, E); }
        } else phase2(p, F);
    }
    if constexpr (PH == 3) {
        {
            const int gw = F.vcu * 8 + F.wave, NGW = F.G * 8, lane = F.lane; float gkx[8];
#pragma unroll
            for (int e = 0; e < 8; ++e) gkx[e] = p.in[I_GKX][(lane & 15) * 8 + e];
            for (int m = gw; m < MROWS; m += NGW) {
                float v[8]; unpack8(*(const u32x4*)((const bf16_t*)(ws + WS_MKV) + (size_t)m * 1024 + lane * 8), v); float s2 = 0.f;
#pragma unroll
                for (int e = 0; e < 8; ++e) s2 += v[e] * v[e];
                s2 += __shfl_xor(s2, 1); s2 += __shfl_xor(s2, 2); s2 += __shfl_xor(s2, 4); s2 += __shfl_xor(s2, 8);
                const float rstd = __builtin_amdgcn_rsqf(s2 * (1.f / 128) + EPS);
#pragma unroll
                for (int e = 0; e < 8; ++e) v[e] = v[e] * rstd * gkx[e];
                *(u32x4*)((bf16_t*)(ws + WS_MKF) + (size_t)m * 512 + lane * 8) = pack8f(v);
            }
        }
        { pg8::Gemm g{(const bf16_t*)(ws + WS_Z) + C_Q, (const bf16_t*)(ws + WS_WQ), T, 1536, 512, ZC}; SO S; S.init(T, 1536, F.G, (int)blockIdx.x);
          pg8::EpiBf16Rs E{(bf16_t*)(ws + WS_QR), 1536, (const float*)(ws + WS_SSQQ), 1.f / 512}; pg8::gemm_phase(F.lds, g, S, E); }
        { pg8::Gemm g{(const bf16_t*)(ws + WS_Z) + C_KV, (const bf16_t*)(ws + WS_WKV), T, 2048, 256, ZC}; SO S; S.init(T, 2048, F.G, (int)blockIdx.x);
          pg8::EpiBf16Rs E{(bf16_t*)(ws + WS_KVR), 2048, (const float*)(ws + WS_SSQKV), 1.f / 256}; pg8::gemm_phase(F.lds, g, S, E);
          pg8::Unit u; for (int i = 0; S.next(i, u); ++i) kv_post(ws, p.in[I_GKMLA], u, F.tid); }
        { pg8::Gemm g{(const bf16_t*)(ws + WS_DP), (const bf16_t*)(ws + WS_WPOOL), T, 512, 512, 512}; SO S; S.init(T, 512, F.G, (int)blockIdx.x);
          pg8::EpiBf16 E{(bf16_t*)(ws + WS_Y), 2048}; pg8::gemm_phase(F.lds, g, S, E); }
    }
    if constexpr (PH == 4) { }
    if constexpr (PH == 5) { phase5(p, F, (char*)lds); }
    if constexpr (PH == 6) {
        pg8::Gemm g{(const bf16_t*)(ws + WS_Y), (const bf16_t*)(ws + WS_WO), T, DM, DM, DM}; SO S; S.init(T, DM, F.G, (int)blockIdx.x);
        pg8::EpiResNorm E{p.in[I_X], p.out, p.in[I_GFFN], (bf16_t*)(ws + WS_H2), (float*)(ws + WS_SS), DM}; pg8::gemm_phase(F.lds, g, S, E);
    }
    if constexpr (PH == 8) {
        pg8::Gemm g{(const bf16_t*)(ws + WS_H2), (const bf16_t*)(ws + WS_WG), T, DFF, DM, DM}; SO S; S.init(T, DFF, F.G, (int)blockIdx.x);
        pg8::EpiBf16Rs E{(bf16_t*)(ws + WS_G), DFF, (const float*)(ws + WS_SS), 1.f / DM}; pg8::gemm_phase(F.lds, g, S, E);
    }
    if constexpr (PH == 9) {
        pg8::Gemm g{(const bf16_t*)(ws + WS_H2), (const bf16_t*)(ws + WS_WU), T, DFF, DM, DM}; SO S; S.init(T, DFF, F.G, (int)blockIdx.x);
        pg8::EpiGlu E{(const bf16_t*)(ws + WS_G), p.in[I_CONVW], p.in[I_CONVB], (bf16_t*)(ws + WS_ACT), (const float*)(ws + WS_SS)}; pg8::gemm_phase(F.lds, g, S, E);
    }
    if constexpr (PH == 10) {
        pg8::Gemm g{(const bf16_t*)(ws + WS_ACT), (const bf16_t*)(ws + WS_WD), T, DM, DFF, DFF}; SO S; S.init(T, DM, F.G, (int)blockIdx.x);
        pg8::EpiResF32 E{p.out, p.out, DM}; pg8::gemm_phase(F.lds, g, S, E);
    }
}

__global__ void __launch_bounds__(512, 2) mk_fwd(Params p) {
    extern __shared__ __attribute__((aligned(16))) unsigned char lds[];
    Frame F;
    F.lds = (LAS unsigned char*)lds;
    F.tid = threadIdx.x; F.lane = F.tid & 63; F.wave = __builtin_amdgcn_readfirstlane(F.tid >> 6);
    F.G = gridDim.x; { const int bx = blockIdx.x; F.vcu = (F.G % 8 == 0) ? (bx % 8) * (F.G / 8) + bx / 8 : bx; }
    unsigned char* ws = p.ws;
    const int lo = p.ph_lo, hi = p.ph_hi;
    volatile LAS unsigned* MISC = (volatile LAS unsigned*)(F.lds + 131072 + 320);
    if (F.tid < 32) MISC[F.tid] = 0u;
    __syncthreads();
    XcdBarrier bar = xcd_barrier_post((unsigned*)ws, MISC + 8);
#ifndef PH_MASK
#define PH_MASK 0x7ff
#endif
#define IN(k) (((PH_MASK >> (k)) & 1) && lo <= (k) && (k) < hi)
#define SEAM(k) do { if (IN(k) && IN((k) + 1)) xcd_barrier(bar); } while (0)
    if (lo < 0) { __threadfence(); cg::this_grid().sync(); }
#ifndef DUP_MASK
#define DUP_MASK 0
#endif
#define PHASE(k) do { if (IN(k)) { run_phase<k>(p, F, lds); if ((DUP_MASK >> (k)) & 1) { xcd_barrier(bar); run_phase<k>(p, F, lds); } } SEAM(k); } while (0)
    PHASE(0); PHASE(1); PHASE(2); PHASE(3); PHASE(5); PHASE(6); PHASE(8); PHASE(9);
    if (IN(10)) run_phase<10>(p, F, lds);
#undef PHASE
#undef IN
#undef SEAM
}

extern "C" void kernel_launch(void* const* d_in, const int* in_sizes, int n_in, void* d_out, int out_size, void* d_ws, size_t ws_size, hipStream_t stream) {
    static int grid = 0;
    if (grid == 0) {
        if (n_in != 23 || in_sizes[0] != T * DM || out_size != T * DM || ws_size < WS_END) {
            fprintf(stderr, "kernel_launch: unexpected shapes (n_in %d, in0 %d, out %d, ws %zu)\n", n_in, n_in > 0 ? in_sizes[0] : -1, out_size, ws_size); grid = -1; return; }
        int dev = 0, cus = 0, per_cu = 0;
        (void)hipGetDevice(&dev); (void)hipDeviceGetAttribute(&cus, hipDeviceAttributeMultiprocessorCount, dev);
        if (hipFuncSetAttribute((const void*)mk_fwd, hipFuncAttributeMaxDynamicSharedMemorySize, LDS_BYTES) != hipSuccess) { fprintf(stderr, "kernel_launch: hipFuncSetAttribute failed\n"); grid = -1; return; }
        if (hipOccupancyMaxActiveBlocksPerMultiprocessor(&per_cu, (const void*)mk_fwd, 512, LDS_BYTES) != hipSuccess || per_cu < 1) { fprintf(stderr, "kernel_launch: occupancy query says %d\n", per_cu); per_cu = 1; }
        (void)hipGetLastError();
        grid = cus * per_cu;
        if (grid <= 0) grid = 256;
    }
    if (grid < 0) return;
    Params p{};
    for (int i = 0; i < 23; ++i) p.in[i] = (const float*)d_in[i];
    p.out = (float*)d_out; p.ws = (unsigned char*)d_ws;
    for (int i = 0; i < 32; ++i) p.inv_freq[i] = 1.0f / powf(10000.0f, (float)i / 32.0f);
#if MK_SPLIT
    for (int ph = 0; ph < NPHASE; ++ph) { p.ph_lo = ph; p.ph_hi = ph + 1; hipLaunchKernelGGL(mk_fwd, dim3(grid), dim3(512), LDS_BYTES, stream, p); }
#else
    p.ph_lo = 0; p.ph_hi = NPHASE;
    (void)hipMemsetAsync(d_ws, 0, 16384, stream);
    void* args[] = {&p};
    hipError_t e = hipLaunchCooperativeKernel((const void*)mk_fwd, dim3(grid), dim3(512), args, LDS_BYTES, stream);
    if (e != hipSuccess) fprintf(stderr, "cooperative launch failed: %s (grid %d)\n", hipGetErrorString(e), grid);
#endif
}
```
